# Optimizing an MI355X kernel written in HIP

```python
import jax, jax.numpy as jnp
from jax import lax
import numpy as np

D_MODEL = 1024
BATCH = 8
SEQ = 2048
DEPTH = 4
DEC_BATCH = 128
DEC_SEQ = 4
PAST_LEN = 16384
PAGE_SIZE = 128

N_META = 16
HGRN_HEADS = 8
HGRN_DK = 128
HGRN_DV = D_MODEL // HGRN_HEADS
QK_W = HGRN_HEADS * HGRN_DK
V_W = HGRN_HEADS * HGRN_DV
CHUNK = 64
PAD_FRONT = CHUNK - N_META
CONV_K = 3
CONV_W = 1024
D_FF = 2816
IN_COLS = 2 * QK_W + 2 * V_W + 3 * CONV_W + 2 * D_MODEL
ALPHA = (2 * DEPTH) ** 0.25
BETA = (8 * DEPTH) ** -0.25
LN_EPS = 1e-5
RMS_EPS = 1e-6

kernel_name = "hgrn2_shortconv_gated_hybrid_step"


def _layernorm(x, g, b):
    xf = x.astype(jnp.float32)
    mu = jnp.mean(xf, axis=-1, keepdims=True)
    var = jnp.mean(jnp.square(xf - mu), axis=-1, keepdims=True)
    y = (xf - mu) * lax.rsqrt(var + LN_EPS) * g.astype(jnp.float32) + b.astype(jnp.float32)
    return y.astype(x.dtype)


def _swiglu(x, w_gu, w_down):
    gu = jnp.einsum('btd,df->btf', x, w_gu)
    g, u = jnp.split(gu, 2, axis=-1)
    return jnp.einsum('btf,fd->btd', jax.nn.silu(g) * u, w_down)


def _gla_chunk(S, qkvg):
    q, k, v, g = qkvg
    C = q.shape[2]
    b = jnp.cumsum(g, axis=2)
    causal = jnp.tril(jnp.ones((C, C), dtype=bool))
    diff = b[:, :, :, None, :] - b[:, :, None, :, :]
    decay = jnp.exp(jnp.where(causal[None, None, :, :, None], diff, -jnp.inf))
    scores = jnp.einsum('bhtd,bhsd,bhtsd->bhts', q, k, decay)
    o = jnp.einsum('bhts,bhsv->bhtv', scores, v) + jnp.einsum('bhtd,bhdv->bhtv', q * jnp.exp(b), S)
    b_last = b[:, :, -1:, :]
    S_new = jnp.exp(b_last[:, :, 0, :, None]) * S + jnp.einsum('bhsd,bhsv->bhdv', k * jnp.exp(b_last - b), v)
    return S_new, o


def _hgrn_recurrence(q, k, v, log_f, S0, chunk):
    Bn, H, T, _ = q.shape
    nc = T // chunk

    def split(a):
        return jnp.moveaxis(a.reshape(Bn, H, nc, chunk, a.shape[-1]), 2, 0)

    S, o = lax.scan(_gla_chunk, S0, (split(q), split(k), split(v), split(log_f)))
    o = jnp.moveaxis(o, 0, 2).reshape(Bn, H, T, HGRN_DV)
    return o, S


def _heads(a, d, pad):
    a = a.reshape(a.shape[0], a.shape[1], HGRN_HEADS, d)
    a = jnp.pad(a, ((0, 0), (pad, 0), (0, 0), (0, 0)))
    return a.transpose(0, 2, 1, 3)


def _token_mixer(x, S0, conv_buf, lb, pad, chunk, w_in, norm_w, conv_w, w_a, w_b, w_o):
    Bn, T, _ = x.shape
    z = jnp.einsum('btd,dc->btc', x, w_in)
    idx = [int(i) for i in np.cumsum([QK_W, QK_W, V_W, V_W, CONV_W, CONV_W, CONV_W, D_MODEL])]
    q, f_pre, v, og, b_gate, c_gate, h, gate_a, gate_b = jnp.split(z, idx, axis=-1)

    lb = lb.astype(jnp.float32)
    log_f = jnp.logaddexp(jnp.log(lb), jnp.log1p(-lb) + jax.nn.log_sigmoid(f_pre.astype(jnp.float32)))
    k = -jnp.expm1(log_f)
    q = jax.nn.silu(q.astype(jnp.float32))
    o, S_new = _hgrn_recurrence(_heads(q, HGRN_DK, pad), _heads(k, HGRN_DK, pad),
                                _heads(v.astype(jnp.float32), HGRN_DV, pad), _heads(log_f, HGRN_DK, pad),
                                S0.astype(jnp.float32), chunk)
    o = o[:, :, pad:].transpose(0, 2, 1, 3)
    o = o * lax.rsqrt(jnp.mean(jnp.square(o), axis=-1, keepdims=True) + RMS_EPS) * norm_w.astype(jnp.float32)
    og = og.reshape(Bn, T, HGRN_HEADS, HGRN_DV).astype(jnp.float32)
    o = (o * jax.nn.silu(og)).reshape(Bn, T, V_W).astype(x.dtype)
    y_a = jnp.einsum('btc,cd->btd', o, w_a)

    u = c_gate * h
    uu = jnp.concatenate([conv_buf.astype(u.dtype), u], axis=1)
    conv = conv_w[0] * uu[:, 0:T]
    for j in range(1, CONV_K):
        conv = conv + conv_w[j] * uu[:, j:j + T]
    new_buf = uu[:, T:]
    y_b = jnp.einsum('btc,cd->btd', b_gate * conv, w_b)

    m = jax.nn.sigmoid(gate_a) * y_a + jax.nn.sigmoid(gate_b) * y_b
    out = jnp.einsum('btd,de->bte', m, w_o)
    return out, S_new.astype(x.dtype), new_buf


def _trunk(x, S_init, buf_init, pad, chunk, lb_all, p):
    new_S, new_buf = [], []
    for l in range(DEPTH):
        x = _layernorm(ALPHA * x + 0.5 * _swiglu(x, p['ffn1_w_gu'][l], p['ffn1_w_down'][l]),
                       p['ln_g'][l, 0], p['ln_b'][l, 0])
        m, S, buf = _token_mixer(x, S_init[l], buf_init[l], lb_all[l], pad, chunk,
                                 p['w_in'][l], p['hgrn_norm_w'][l], p['conv_w'][l],
                                 p['w_branch_a'][l], p['w_branch_b'][l], p['w_out'][l])
        x = _layernorm(ALPHA * x + m, p['ln_g'][l, 1], p['ln_b'][l, 1])
        x = _layernorm(ALPHA * x + 0.5 * _swiglu(x, p['ffn2_w_gu'][l], p['ffn2_w_down'][l]),
                       p['ln_g'][l, 2], p['ln_b'][l, 2])
        new_S.append(S)
        new_buf.append(buf)
    return x, jnp.stack(new_S), jnp.stack(new_buf)


def setup_inputs(seed: int = 0) -> dict:
    key = jax.random.key(seed)
    ks = jax.random.split(key, 20)
    nrm = jax.random.normal
    f32 = jnp.float32
    return {
        "x_prompt": nrm(ks[0], (BATCH, SEQ, D_MODEL), f32),
        "x_sample": nrm(ks[1], (DEC_BATCH, DEC_SEQ, D_MODEL), f32),
        "state_hgrn": 0.3 * nrm(ks[2], (DEPTH, DEC_BATCH, HGRN_HEADS, HGRN_DK, HGRN_DV), f32),
        "state_conv": nrm(ks[3], (DEPTH, DEC_BATCH, CONV_K - 1, CONV_W), f32),
        "meta_tokens": nrm(ks[4], (N_META, D_MODEL), f32),
        "w_in": nrm(ks[5], (DEPTH, D_MODEL, IN_COLS), f32) * D_MODEL ** -0.5,
        "hgrn_lb_logits": 0.1 * nrm(ks[6], (DEPTH, QK_W), f32),
        "hgrn_norm_w": 1.0 + 0.02 * nrm(ks[7], (DEPTH, HGRN_DV), f32),
        "conv_w": nrm(ks[8], (DEPTH, CONV_K, CONV_W), f32) * CONV_K ** -0.5,
        "w_branch_a": nrm(ks[9], (DEPTH, V_W, D_MODEL), f32) * (V_W ** -0.5 * BETA),
        "w_branch_b": nrm(ks[10], (DEPTH, CONV_W, D_MODEL), f32) * (CONV_W ** -0.5 * BETA),
        "w_out": nrm(ks[11], (DEPTH, D_MODEL, D_MODEL), f32) * (D_MODEL ** -0.5 * BETA),
        "ffn1_w_gu": nrm(ks[12], (DEPTH, D_MODEL, 2 * D_FF), f32) * D_MODEL ** -0.5,
        "ffn1_w_down": nrm(ks[13], (DEPTH, D_FF, D_MODEL), f32) * (D_FF ** -0.5 * BETA),
        "ffn2_w_gu": nrm(ks[14], (DEPTH, D_MODEL, 2 * D_FF), f32) * D_MODEL ** -0.5,
        "ffn2_w_down": nrm(ks[15], (DEPTH, D_FF, D_MODEL), f32) * (D_FF ** -0.5 * BETA),
        "ln_g": 1.0 + 0.02 * nrm(ks[16], (DEPTH, 3, D_MODEL), f32),
        "ln_b": 0.02 * nrm(ks[17], (DEPTH, 3, D_MODEL), f32),
    }


def reference(x_prompt, x_sample, state_hgrn, state_conv, meta_tokens, w_in, hgrn_lb_logits,
              hgrn_norm_w, conv_w, w_branch_a, w_branch_b, w_out, ffn1_w_gu, ffn1_w_down,
              ffn2_w_gu, ffn2_w_down, ln_g, ln_b):
    p = dict(w_in=w_in, hgrn_norm_w=hgrn_norm_w, conv_w=conv_w, w_branch_a=w_branch_a,
             w_branch_b=w_branch_b, w_out=w_out, ffn1_w_gu=ffn1_w_gu, ffn1_w_down=ffn1_w_down,
             ffn2_w_gu=ffn2_w_gu, ffn2_w_down=ffn2_w_down, ln_g=ln_g, ln_b=ln_b)
    lb_all = jnp.cumsum(jax.nn.softmax(hgrn_lb_logits.astype(jnp.float32), axis=0), axis=0)
    lb_all = lb_all - lb_all[0:1]

    bp = x_prompt.shape[0]
    meta = jnp.broadcast_to(meta_tokens[None].astype(x_prompt.dtype), (bp, N_META, D_MODEL))
    xp = jnp.concatenate([meta, x_prompt], axis=1)
    S0p = jnp.zeros((DEPTH, bp, HGRN_HEADS, HGRN_DK, HGRN_DV), x_prompt.dtype)
    buf0p = jnp.zeros((DEPTH, bp, CONV_K - 1, CONV_W), x_prompt.dtype)
    yp, new_hgrn_prompt, new_conv_prompt = _trunk(xp, S0p, buf0p, PAD_FRONT, CHUNK, lb_all, p)
    y_prompt = yp[:, N_META:]

    y_sample, new_hgrn_sample, new_conv_sample = _trunk(x_sample, state_hgrn, state_conv, 0,
                                                        x_sample.shape[1], lb_all, p)
    return (y_prompt, y_sample, new_hgrn_prompt, new_conv_prompt, new_hgrn_sample, new_conv_sample)
```

```cpp
#include <hip/hip_runtime.h>
#include <hip/hip_cooperative_groups.h>
#include <cstdio>
#include <cstdint>
namespace cg = cooperative_groups;

#define LAS __attribute__((address_space(3)))
typedef _Float16 f16;
typedef _Float16 f16x8 __attribute__((ext_vector_type(8)));
typedef _Float16 f16x4 __attribute__((ext_vector_type(4)));
typedef _Float16 f16x2 __attribute__((ext_vector_type(2)));
typedef short s16x8 __attribute__((ext_vector_type(8)));
typedef float f32x4 __attribute__((ext_vector_type(4)));
typedef float f32x2 __attribute__((ext_vector_type(2)));
typedef unsigned u32x4 __attribute__((ext_vector_type(4)));
typedef unsigned u32x2 __attribute__((ext_vector_type(2)));

constexpr int D = 1024, DFF = 2816, NIN = 9216, NLAYER = 4;
constexpr int BP = 8, TP = 2064, SEQP = 2048, NMETA = 16, MP = BP * TP;
constexpr int BS = 128, TS = 4, MS = BS * TS;
constexpr int MROWS = MP + MS;
constexpr int MAIN = BP * SEQP;
constexpr int META0 = MAIN, SAMP0 = MAIN + BP * NMETA;
constexpr int NTAIL = MROWS - MAIN;
constexpr int MPAD = 17152;
constexpr int NH = 8, DK = 128, DV = 128;
constexpr float ALPHA = 1.6817928305074290f;
constexpr float LN_EPS = 1e-5f, RMS_EPS = 1e-6f;

constexpr size_t O_YP = 0, O_YS = (size_t)BP * SEQP * D, O_HP = O_YS + (size_t)MS * D, O_CP = O_HP + (size_t)NLAYER * BP * NH * DK * DV,
                 O_HS = O_CP + (size_t)NLAYER * BP * 2 * D, O_CS = O_HS + (size_t)NLAYER * BS * NH * DK * DV;

constexpr size_t W_GU1 = 0, W_DN1 = W_GU1 + (size_t)2 * DFF * D, W_IN = W_DN1 + (size_t)D * DFF, W_A = W_IN + (size_t)NIN * D, W_B = W_A + (size_t)D * D,
                 W_O = W_B + (size_t)D * D, W_GU2 = W_O + (size_t)D * D, W_DN2 = W_GU2 + (size_t)2 * DFF * D, W_LAYER = W_DN2 + (size_t)D * DFF;

constexpr size_t AL(size_t x) { return (x + 4095) & ~(size_t)4095; }
constexpr size_t WS_CTL = 0;
constexpr size_t WS_LB = 1u << 20;
constexpr size_t WS_W = WS_LB + 65536;
constexpr size_t WS_X = AL(WS_W + W_LAYER * NLAYER * 2);
constexpr size_t SZ16 = (size_t)MPAD * D * 2, SZ32 = (size_t)MPAD * D * 4;
constexpr size_t WS_XH = AL(WS_X + SZ32);
constexpr size_t WS_Q = AL(WS_XH + SZ16);
constexpr size_t WS_V = WS_Q + SZ16;
constexpr size_t WS_SOG = WS_V + SZ16;
constexpr size_t WS_H = WS_Q;
static_assert((size_t)MPAD * DFF * 2 <= 3 * SZ16, "H overlay");
constexpr size_t WS_LF = AL(WS_SOG + SZ16);
constexpr size_t WS_BG = AL(WS_LF + SZ32);
constexpr size_t WS_U = WS_BG + SZ16;
constexpr size_t WS_SGA = WS_U + SZ16;
constexpr size_t WS_SGB = WS_SGA + SZ16;
constexpr size_t WS_O = WS_SGB + SZ16;
constexpr size_t WS_CB = WS_O + SZ16;
constexpr size_t WS_MM = WS_CB + SZ16;
constexpr size_t WS_SS = AL(WS_MM + SZ16);
constexpr size_t WS_END = WS_SS + (size_t)MPAD * 64 * 4;

constexpr int LDS_BYTES = 147456;
constexpr int XB_LDS_OFF = 147456 - 64;

__device__ __forceinline__ unsigned f2bf(float f) { unsigned u = __builtin_bit_cast(unsigned, f); return (u + 0x7fffu + ((u >> 16) & 1u)) >> 16; }
__device__ __forceinline__ unsigned pkh(float lo, float hi) { f16x2 v = {(f16)lo, (f16)hi}; return __builtin_bit_cast(unsigned, v); }
__device__ __forceinline__ unsigned pkb(float lo, float hi) { unsigned r; asm("v_cvt_pk_bf16_f32 %0, %1, %2" : "=v"(r) : "v"(lo), "v"(hi)); return r; }
__device__ __forceinline__ float sigmoidf_(float x) { return __builtin_amdgcn_rcpf(1.0f + __expf(-x)); }
#define LDS_WAIT() asm volatile("s_waitcnt lgkmcnt(0)" ::: "memory")
__device__ __forceinline__ int opaque_tid(int wave_s) { int t; asm volatile("v_mbcnt_lo_u32_b32 %0, -1, 0\n\tv_mbcnt_hi_u32_b32 %0, -1, %0" : "=v"(t)); return wave_s * 64 + t; }
template <int IDX> __device__ __forceinline__ unsigned char* karg() { __attribute__((address_space(1))) unsigned char* v;
#if defined(__HIP_DEVICE_COMPILE__)
    auto p = __builtin_amdgcn_kernarg_segment_ptr();
    asm volatile("s_load_dwordx2 %0, %1, %2\n\ts_waitcnt lgkmcnt(0)" : "=s"(v) : "s"(p), "n"(IDX * 8));
#else
    v = nullptr;
#endif
    return (unsigned char*)v; }
__device__ __forceinline__ int opaque_s(int x) { asm volatile("" : "+s"(x)); return x; }

__device__ __forceinline__ unsigned pn_ld(unsigned* p)              { return __hip_atomic_load(p, __ATOMIC_RELAXED, __HIP_MEMORY_SCOPE_AGENT); }
__device__ __forceinline__ unsigned pn_add(unsigned* p, unsigned v) { return __hip_atomic_fetch_add(p, v, __ATOMIC_RELAXED, __HIP_MEMORY_SCOPE_AGENT); }
__device__ __forceinline__ void slot_st(f32x2* p, f32x2 v) { __hip_atomic_store((unsigned long long*)p, __builtin_bit_cast(unsigned long long, v), __ATOMIC_RELAXED, __HIP_MEMORY_SCOPE_AGENT); }
__device__ __forceinline__ f32x2 slot_ld(const f32x2* p) { return __builtin_bit_cast(f32x2, __hip_atomic_load((unsigned long long*)p, __ATOMIC_RELAXED, __HIP_MEMORY_SCOPE_AGENT)); }
__device__ __forceinline__ void panel_arrive(unsigned* cnt, int tid) {
    asm volatile("s_waitcnt vmcnt(0)" ::: "memory");
    __syncthreads();
    if (tid == 0) { __builtin_amdgcn_fence(__ATOMIC_RELEASE, "agent"); asm volatile("s_waitcnt vmcnt(0)" ::: "memory"); (void)pn_add(cnt, 1u); }
}
__device__ __forceinline__ void panel_wait(unsigned* cnt, unsigned target, int tid) {
    if (tid == 0) { unsigned sp = 0u; while (pn_ld(cnt) < target) { __builtin_amdgcn_s_sleep(1); if (++sp > (1u << 22)) break; }
        __builtin_amdgcn_fence(__ATOMIC_ACQUIRE, "agent"); asm volatile("s_waitcnt vmcnt(0)" ::: "memory"); }
    __syncthreads();
}
constexpr int CW_PANEL = 8192;
constexpr size_t XS_MAIN = 0, XS_TAIL = 1u << 20;

namespace pg8 {
constexpr int BM = 256, BK = 64, HALF = 128, HTB = HALF * BK * 2, STAGE_BYTES = 8 * HTB, NXCD = 8, WGM = 4;
__host__ __device__ __forceinline__ int lds_byte(int r, int c) { const int st = (r >> 4) * 2 + (c >> 5), rr = r & 15, cc = c & 31, ob = rr * 64 + cc * 2; return st * 1024 + (ob ^ (((ob >> 9) & 1) << 5)); }
__host__ __device__ __forceinline__ void stage_rc(int b, int& R, int& C) { const int st = b / 1024, sb = b % 1024, swz = sb ^ (((sb >> 9) & 1) << 5); R = (st >> 1) * 16 + swz / 64; C = (st & 1) * 32 + (swz % 64) / 2; }
__host__ __device__ __forceinline__ int perm32(int rho) { const int n = rho >> 4, i = rho & 15; return 8 * (i >> 2) + 4 * n + (i & 3); }

struct Unit { int pm, pn; };
struct Gemm { const f16* A; const f16* Bt; int M, N, K; };

struct StaticOrder {
    int nM, nN, nwg, G, c;
    __device__ void init(int M, int N, int G_, int c_) { nM = M / BM; nN = N / BM; nwg = nM * nN; G = G_; c = c_; }
    __device__ bool next(int i, Unit& u) const {
        const long L = (long)i * G + c; if (L >= nwg) return false;
        int wgid = (int)L; { const int q = nwg / NXCD, r = nwg % NXCD, xcd = wgid % NXCD, off = wgid / NXCD; wgid = (xcd < r ? xcd * (q + 1) : r * (q + 1) + (xcd - r) * q) + off; }
        const int nig = WGM * nN, gid = wgid / nig, fm = gid * WGM, gsz = (nM - fm) < WGM ? (nM - fm) : WGM;
        u.pm = fm + ((wgid % nig) % gsz); u.pn = (wgid % nig) / gsz; return true;
    }
};

template <class Epi>
__device__ __forceinline__ void gemm_phase(LAS unsigned char* lds, const Gemm g, const StaticOrder& S, const Epi& E, int wave_s) {
    const int tid = opaque_tid(wave_s), wid = __builtin_amdgcn_readfirstlane(tid >> 6), lane = tid & 63, wr = wid >> 2, wc = wid & 3, fr = lane & 15, fq = lane >> 4;
    const int K = g.K, nt = K / BK;
    unsigned voffA[2], voffB[2];
#pragma unroll
    for (int i = 0; i < 2; ++i) { int R, C; stage_rc(tid * 16 + i * 8192, R, C); const int Rb = Epi::PERM ? ((R & ~31) + perm32(R & 31)) : R;
        voffA[i] = (unsigned)(R * K + C) * 2u; voffB[i] = (unsigned)(Rb * K + C) * 2u; }
    const size_t kstep = (size_t)(BK * 2);
    const size_t hstep = (size_t)HALF * K * 2;
    const size_t tstep = 2 * hstep;
    const unsigned ldsw = (unsigned)wid * 1024u;
    const int aoff = lds_byte(wr * 64 + fr, fq * 8), boff = lds_byte(wc * 32 + fr, fq * 8);
#define PG8_SA(b, h) (((b) * 2 + (h)) * HTB)
#define PG8_SB(b, h) ((4 + (b) * 2 + (h)) * HTB)
#define PG8_STAGE(bufoff, gbase, voff) do { _Pragma("unroll") for (int _i = 0; _i < 2; ++_i) \
        __builtin_amdgcn_global_load_lds((const unsigned*)((const char*)(gbase) + (voff)[_i]), (LAS unsigned*)(lds + (bufoff) + ldsw + _i * 8192), 16, 0, 0); } while (0)
#define PG8_LDA(dst, b, h) do { _Pragma("unroll") for (int m = 0; m < 4; ++m) _Pragma("unroll") for (int k = 0; k < 2; ++k) dst[m][k] = *(const LAS f16x8*)(lds + PG8_SA(b, h) + aoff + m * 2048 + k * 1024); } while (0)
#define PG8_LDB(dst, b, h) do { _Pragma("unroll") for (int n = 0; n < 2; ++n) _Pragma("unroll") for (int k = 0; k < 2; ++k) dst[n][k] = *(const LAS f16x8*)(lds + PG8_SB(b, h) + boff + n * 2048 + k * 1024); } while (0)
#define PG8_MMA(ai, bj, At, Bt) do { __builtin_amdgcn_s_setprio(1); _Pragma("unroll") for (int m = 0; m < 4; ++m) _Pragma("unroll") for (int n = 0; n < 2; ++n) _Pragma("unroll") for (int k = 0; k < 2; ++k) \
        acc[ai][bj][m][n] = __builtin_amdgcn_mfma_f32_16x16x32_f16(Bt[n][k], At[m][k], acc[ai][bj][m][n], 0, 0, 0); __builtin_amdgcn_s_setprio(0); } while (0)
#define PG8_WAIT_V(n) asm volatile("s_waitcnt vmcnt(" #n ")" ::: "memory")
#define PG8_WAIT_L(n) asm volatile("s_waitcnt lgkmcnt(" #n ")" ::: "memory")
#define PG8_BAR __builtin_amdgcn_s_barrier()
#define PG8_SCHED __builtin_amdgcn_sched_barrier(0)
    Unit cur, nxt; int ui = 0;
    if (!S.next(0, cur)) return;
    f32x4 acc[2][2][4][2];
#pragma unroll
    for (int a = 0; a < 2; ++a)
#pragma unroll
        for (int b = 0; b < 2; ++b)
#pragma unroll
            for (int m = 0; m < 4; ++m)
#pragma unroll
                for (int n = 0; n < 2; ++n) acc[a][b][m][n] = (f32x4){0.f, 0.f, 0.f, 0.f};
    f16x8 At[4][2], B0[2][2], B1[2][2];
    const char* cA = (const char*)g.A + (size_t)cur.pm * tstep; const char* cB = (const char*)g.Bt + (size_t)cur.pn * tstep;
    PG8_STAGE(PG8_SB(0, 0), cB, voffB); PG8_STAGE(PG8_SA(0, 0), cA, voffA); PG8_STAGE(PG8_SB(0, 1), cB + hstep, voffB); PG8_STAGE(PG8_SA(0, 1), cA + hstep, voffA);
    if (wr == 1) PG8_BAR;
    PG8_WAIT_V(4); PG8_BAR;
    PG8_STAGE(PG8_SB(1, 0), cB + kstep, voffB); PG8_STAGE(PG8_SA(1, 0), cA + kstep, voffA); PG8_STAGE(PG8_SB(1, 1), cB + hstep + kstep, voffB);
    PG8_WAIT_V(6); PG8_BAR;
    for (;;) {
        const bool has_next = S.next(ui + 1, nxt);
        const char* nA = has_next ? (const char*)g.A + (size_t)nxt.pm * tstep : cA; const char* nB = has_next ? (const char*)g.Bt + (size_t)nxt.pn * tstep : cB;
#define PG8_KBODY \
            const bool last = (t == nt - 2); \
            const char* a1 = cA + (size_t)(t + 1) * kstep; \
            const char* a2 = last ? nA : cA + (size_t)(t + 2) * kstep; const char* b2 = last ? nB : cB + (size_t)(t + 2) * kstep; \
            const char* a3 = a2 + kstep; const char* b3 = b2 + kstep; \
            PG8_LDB(B0, 0, 0); PG8_SCHED; PG8_LDA(At, 0, 0); PG8_STAGE(PG8_SA(1, 1), a1 + hstep, voffA); \
            PG8_WAIT_L(8); PG8_BAR; PG8_WAIT_L(0); PG8_MMA(0, 0, At, B0); PG8_BAR; PG8_SCHED; \
            PG8_LDB(B1, 0, 1); PG8_STAGE(PG8_SB(0, 0), b2, voffB); \
            PG8_BAR; PG8_WAIT_L(0); PG8_MMA(0, 1, At, B1); PG8_BAR; \
            PG8_LDA(At, 0, 1); PG8_STAGE(PG8_SA(0, 0), a2, voffA); \
            PG8_BAR; PG8_WAIT_L(0); PG8_MMA(1, 0, At, B0); PG8_BAR; PG8_SCHED; \
            PG8_STAGE(PG8_SB(0, 1), b2 + hstep, voffB); \
            PG8_WAIT_V(6); PG8_BAR; PG8_MMA(1, 1, At, B1); PG8_BAR; \
            PG8_LDB(B0, 1, 0); PG8_SCHED; PG8_LDA(At, 1, 0); PG8_STAGE(PG8_SA(0, 1), a2 + hstep, voffA); \
            PG8_WAIT_L(8); PG8_BAR; PG8_WAIT_L(0); PG8_MMA(0, 0, At, B0); PG8_BAR; PG8_SCHED; \
            PG8_LDB(B1, 1, 1); PG8_STAGE(PG8_SB(1, 0), b3, voffB); \
            PG8_BAR; PG8_WAIT_L(0); PG8_MMA(0, 1, At, B1); PG8_BAR; \
            PG8_LDA(At, 1, 1); PG8_STAGE(PG8_SA(1, 0), a3, voffA); \
            PG8_BAR; PG8_WAIT_L(0); PG8_MMA(1, 0, At, B0); PG8_BAR; PG8_SCHED; \
            PG8_STAGE(PG8_SB(1, 1), b3 + hstep, voffB); \
            PG8_WAIT_V(6); PG8_BAR; PG8_MMA(1, 1, At, B1); PG8_BAR;
        if constexpr (Epi::HOOK) {
            for (int t = 0; t < (nt >> 1); t += 2) { PG8_KBODY }
            E.hook(acc, cur, wr, wc, fr, fq);
            for (int t = (nt >> 1); t < nt; t += 2) { PG8_KBODY }
        } else {
            for (int t = 0; t < nt; t += 2) { PG8_KBODY }
        }
#undef PG8_KBODY
        if constexpr (!Epi::AFTER_DRAIN) E(acc, cur, wr, wc, fr, fq);
        if (!has_next) break;
#pragma unroll
        for (int a = 0; a < 2; ++a)
#pragma unroll
            for (int b = 0; b < 2; ++b)
#pragma unroll
                for (int m = 0; m < 4; ++m)
#pragma unroll
                    for (int n = 0; n < 2; ++n) acc[a][b][m][n] = (f32x4){0.f, 0.f, 0.f, 0.f};
        cur = nxt; cA = nA; cB = nB; ++ui;
    }
    PG8_WAIT_V(0);
    if (wr == 0) PG8_BAR;
    PG8_BAR;
    if constexpr (Epi::AFTER_DRAIN) E.fused(acc, cur, wr, wc, fr, fq, lds, tid);
#undef PG8_SA
#undef PG8_SB
#undef PG8_STAGE
#undef PG8_LDA
#undef PG8_LDB
#undef PG8_MMA
#undef PG8_WAIT_V
#undef PG8_WAIT_L
#undef PG8_BAR
#undef PG8_SCHED
}

struct EpiGU {
    static constexpr bool PERM = true, HOOK = false, AFTER_DRAIN = false;
    f16* H;
    __device__ __forceinline__ static bool paired(int) { return true; }
    __device__ __forceinline__ void tail(int row, int pn, int cc0, int cc1, const f32x4& v0, const f32x4& v1) const {
        float h[4];
#pragma unroll
        for (int j = 0; j < 4; ++j) h[j] = v0[j] * sigmoidf_(v0[j]) * v1[j];
        u32x2 w; w.x = pkh(h[0], h[1]); w.y = pkh(h[2], h[3]); *(u32x2*)(H + (size_t)row * DFF + (cc0 - 128 * pn)) = w;
    }
    __device__ __forceinline__ void operator()(const f32x4 (&acc)[2][2][4][2], const Unit& u, int wr, int wc, int fr, int fq) const {
        const int row0 = u.pm * BM + wr * 64 + fr, col0 = u.pn * 128 + wc * 32 + 8 * fq;
#pragma unroll
        for (int ai = 0; ai < 2; ++ai)
#pragma unroll
            for (int m = 0; m < 4; ++m) {
                float h[8];
#pragma unroll
                for (int n = 0; n < 2; ++n)
#pragma unroll
                    for (int j = 0; j < 4; ++j) { const float gv = acc[ai][0][m][n][j], uv = acc[ai][1][m][n][j]; h[n * 4 + j] = gv * sigmoidf_(gv) * uv; }
                u32x4 w; w.x = pkh(h[0], h[1]); w.y = pkh(h[2], h[3]); w.z = pkh(h[4], h[5]); w.w = pkh(h[6], h[7]);
                *(u32x4*)(H + (size_t)(row0 + ai * HALF + m * 16) * DFF + col0) = w;
            }
    }
};
struct EpiResLN {
    static constexpr bool PERM = false, HOOK = false, AFTER_DRAIN = true;
    const f16* XHr; f16* XHw; float* outp; float scale; const float* gam; const float* bet; unsigned char* xs; unsigned* cnt; unsigned inst;
    __device__ __forceinline__ static bool paired(int) { return false; }
    __device__ __forceinline__ void operator()(const f32x4 (&)[2][2][4][2], const Unit&, int, int, int, int) const {}
    __device__ __forceinline__ void fused(f32x4 (&acc)[2][2][4][2], const Unit& u, int wr, int wc, int fr, int fq, LAS unsigned char* lds, int tid) const {
        const int rt0 = wr * 64 + fr, col0 = u.pn * BM + wc * 32 + 4 * fq;
        LAS f32x2* P = (LAS f32x2*)lds; LAS f32x2* ST = (LAS f32x2*)(lds + 8192);
        {
            const f16* px = XHr + (size_t)(u.pm * BM + rt0) * D + col0;
#pragma unroll
            for (int ai = 0; ai < 2; ++ai) {
#pragma unroll
                for (int m = 0; m < 4; ++m) {
                    asm volatile("" : "+v"(px));
                    float sm = 0.f, sq = 0.f;
#pragma unroll
                    for (int bj = 0; bj < 2; ++bj)
#pragma unroll
                        for (int n = 0; n < 2; ++n) { const f16x4 h = *(const f16x4*)(px + bj * HALF + n * 16);
#pragma unroll
                            for (int j = 0; j < 4; ++j) { const float t = (float)h[j] * ALPHA + acc[ai][bj][m][n][j] * scale; acc[ai][bj][m][n][j] = t; sm += t; sq += t * t; } }
                    sm += __shfl_xor(sm, 16); sm += __shfl_xor(sm, 32); sq += __shfl_xor(sq, 16); sq += __shfl_xor(sq, 32);
                    if (fq == 0) P[(ai * HALF + m * 16 + rt0) * 4 + wc] = (f32x2){sm, sq};
                    px += 16 * D;
                    __builtin_amdgcn_sched_barrier(0);
                }
                px += 64 * D;
            }
        }
        __syncthreads();
        f32x2* slot = (f32x2*)(xs + XS_MAIN) + (size_t)(u.pm * 256) * 4;
        if (tid < 256) { const f32x2 a = P[tid * 4 + 0], b = P[tid * 4 + 1], c = P[tid * 4 + 2], d = P[tid * 4 + 3];
            slot_st(slot + u.pn * 256 + tid, (f32x2){(a.x + b.x) + (c.x + d.x), (a.y + b.y) + (c.y + d.y)}); }
        panel_arrive(cnt + 64 * u.pm, tid);
        panel_wait(cnt + 64 * u.pm, 4u * inst, tid);
        if (tid < 256) { const f32x2 a = slot_ld(slot + tid), b = slot_ld(slot + 256 + tid), c = slot_ld(slot + 512 + tid), d = slot_ld(slot + 768 + tid);
            const float mean = ((a.x + b.x) + (c.x + d.x)) * (1.f / D), ex2 = ((a.y + b.y) + (c.y + d.y)) * (1.f / D);
            ST[tid] = (f32x2){mean, 1.0f / sqrtf(fmaxf(ex2 - mean * mean, 0.f) + LN_EPS)}; }
        __syncthreads();
        {
            f32x4 gv[2][2], bv[2][2];
#pragma unroll
            for (int bj = 0; bj < 2; ++bj)
#pragma unroll
                for (int n = 0; n < 2; ++n) { gv[bj][n] = *(const f32x4*)(gam + col0 + bj * HALF + n * 16); bv[bj][n] = *(const f32x4*)(bet + col0 + bj * HALF + n * 16); }
            size_t ro = (size_t)(u.pm * BM + rt0) * D + col0;
#pragma unroll
            for (int ai = 0; ai < 2; ++ai) {
#pragma unroll
                for (int m = 0; m < 4; ++m) {
                    asm volatile("" : "+v"(ro));
                    const f32x2 st = ST[ai * HALF + m * 16 + rt0];
#pragma unroll
                    for (int bj = 0; bj < 2; ++bj)
#pragma unroll
                        for (int n = 0; n < 2; ++n) { const f32x4 y = (acc[ai][bj][m][n] - st.x) * st.y * gv[bj][n] + bv[bj][n];
                            if (outp) *(f32x4*)(outp + ro + bj * HALF + n * 16) = y;
                            else { u32x2 w; w.x = pkh(y.x, y.y); w.y = pkh(y.z, y.w); *(u32x2*)(XHw + ro + bj * HALF + n * 16) = w; } }
                    ro += 16 * D;
                }
                ro += 64 * D;
            }
        }
        __syncthreads();
    }
    __device__ __forceinline__ void tail(int, int, int, int, const f32x4&, const f32x4&) const {}
    __device__ __forceinline__ void tail_fused(int rg, int cg, int wave_s, int fr, int fq, f32x4 v0, f32x4 v1, int tid) const {
        const int rin = 16 * wave_s + fr, row = MAIN + 128 * rg + rin, c0 = 32 * cg + 4 * fq, c1 = c0 + 16;
        const size_t o0 = (size_t)row * D + c0, o1 = (size_t)row * D + c1;
        const f16x4 h0 = *(const f16x4*)(XHr + o0), h1 = *(const f16x4*)(XHr + o1);
        float sm = 0.f, sq = 0.f;
#pragma unroll
        for (int j = 0; j < 4; ++j) { v0[j] = (float)h0[j] * ALPHA + v0[j] * scale; v1[j] = (float)h1[j] * ALPHA + v1[j] * scale; sm += v0[j] + v1[j]; sq += v0[j] * v0[j] + v1[j] * v1[j]; }
        sm += __shfl_xor(sm, 16); sm += __shfl_xor(sm, 32); sq += __shfl_xor(sq, 16); sq += __shfl_xor(sq, 32);
        f32x2* slot = (f32x2*)(xs + XS_TAIL) + (size_t)(rg * 128) * 32;
        if (fq == 0) slot_st(slot + cg * 128 + rin, (f32x2){sm, sq});
        panel_arrive(cnt + 64 * (64 + rg), tid);
        panel_wait(cnt + 64 * (64 + rg), 32u * inst, tid);
        float ts = 0.f, tq = 0.f;
#pragma unroll
        for (int k = 0; k < 8; ++k) { const f32x2 p = slot_ld(slot + (fq * 8 + k) * 128 + rin); ts += p.x; tq += p.y; }
        ts += __shfl_xor(ts, 16); ts += __shfl_xor(ts, 32); tq += __shfl_xor(tq, 16); tq += __shfl_xor(tq, 32);
        const float mean = ts * (1.f / D), rstd = 1.0f / sqrtf(fmaxf(tq * (1.f / D) - mean * mean, 0.f) + LN_EPS);
        const f32x4 g0 = *(const f32x4*)(gam + c0), g1 = *(const f32x4*)(gam + c1), b0 = *(const f32x4*)(bet + c0), b1 = *(const f32x4*)(bet + c1);
        const f32x4 y0 = (v0 - mean) * rstd * g0 + b0, y1 = (v1 - mean) * rstd * g1 + b1;
        if (outp) { if (row >= SAMP0) { float* d = outp + (O_YS - O_YP) + (size_t)(row - SAMP0) * D; *(f32x4*)(d + c0) = y0; *(f32x4*)(d + c1) = y1; } }
        else { u32x2 w0, w1; w0.x = pkh(y0.x, y0.y); w0.y = pkh(y0.z, y0.w); w1.x = pkh(y1.x, y1.y); w1.y = pkh(y1.z, y1.w); *(u32x2*)(XHw + o0) = w0; *(u32x2*)(XHw + o1) = w1; }
    }
};
struct EpiMerge {
    static constexpr bool PERM = false, HOOK = true, AFTER_DRAIN = false;
    const f16* SGA; const f16* SGB; f16* MM;
    __device__ __forceinline__ static bool paired(int) { return false; }
    __device__ __forceinline__ static float ratio(f16 a, f16 b) { return (float)a * __builtin_amdgcn_rcpf(fmaxf((float)b, 1e-4f)); }
    __device__ __forceinline__ void tail_hook(int row, int cc0, int cc1, f32x4& v0, f32x4& v1) const {
        const size_t o0 = (size_t)row * D + cc0, o1 = (size_t)row * D + cc1;
        const f16x4 a0 = *(const f16x4*)(SGA + o0), a1 = *(const f16x4*)(SGA + o1), b0 = *(const f16x4*)(SGB + o0), b1 = *(const f16x4*)(SGB + o1);
#pragma unroll
        for (int j = 0; j < 4; ++j) { v0[j] *= ratio(a0[j], b0[j]); v1[j] *= ratio(a1[j], b1[j]); }
    }
    __device__ __forceinline__ void tail(int row, int pn, int cc0, int cc1, const f32x4& v0, const f32x4& v1) const {
        const size_t o0 = (size_t)row * D + cc0, o1 = (size_t)row * D + cc1; const f16x4 g0 = *(const f16x4*)(SGB + o0), g1 = *(const f16x4*)(SGB + o1);
        float r0[4], r1[4];
#pragma unroll
        for (int j = 0; j < 4; ++j) { r0[j] = v0[j] * fmaxf((float)g0[j], 1e-4f); r1[j] = v1[j] * fmaxf((float)g1[j], 1e-4f); }
        u32x2 w0, w1; w0.x = pkh(r0[0], r0[1]); w0.y = pkh(r0[2], r0[3]); w1.x = pkh(r1[0], r1[1]); w1.y = pkh(r1[2], r1[3]);
        *(u32x2*)(MM + o0) = w0; *(u32x2*)(MM + o1) = w1;
    }
    __device__ __forceinline__ void hook(f32x4 (&acc)[2][2][4][2], const Unit& u, int wr, int wc, int fr, int fq) const {
        const int row0 = u.pm * BM + wr * 64 + fr, col0 = u.pn * BM + wc * 32 + 4 * fq;
        const f16* pa = SGA + (size_t)row0 * D + col0; const f16* pb = SGB + (size_t)row0 * D + col0;
#pragma unroll
        for (int ai = 0; ai < 2; ++ai) {
#pragma unroll
            for (int m = 0; m < 4; ++m) {
                asm volatile("" : "+v"(pa), "+v"(pb));
#pragma unroll
                for (int bj = 0; bj < 2; ++bj)
#pragma unroll
                    for (int n = 0; n < 2; ++n) { const f16x4 ga = *(const f16x4*)(pa + bj * HALF + n * 16), gb = *(const f16x4*)(pb + bj * HALF + n * 16);
#pragma unroll
                        for (int j = 0; j < 4; ++j) acc[ai][bj][m][n][j] *= ratio(ga[j], gb[j]); }
                pa += 16 * D; pb += 16 * D;
                __builtin_amdgcn_sched_barrier(0);
            }
            pa += 64 * D; pb += 64 * D;
        }
    }
    __device__ __forceinline__ void operator()(const f32x4 (&acc)[2][2][4][2], const Unit& u, int wr, int wc, int fr, int fq) const {
        const int row0 = u.pm * BM + wr * 64 + fr, col0 = u.pn * BM + wc * 32 + 4 * fq;
#pragma unroll
        for (int ai = 0; ai < 2; ++ai)
#pragma unroll
            for (int m = 0; m < 4; ++m) { const size_t ro = (size_t)(row0 + ai * HALF + m * 16) * D + col0;
#pragma unroll
                for (int bj = 0; bj < 2; ++bj)
#pragma unroll
                    for (int n = 0; n < 2; ++n) { const size_t o = ro + bj * HALF + n * 16; const f16x4 gq = *(const f16x4*)(SGB + o);
                        u32x2 w; w.x = pkh(acc[ai][bj][m][n].x * fmaxf((float)gq.x, 1e-4f), acc[ai][bj][m][n].y * fmaxf((float)gq.y, 1e-4f));
                        w.y = pkh(acc[ai][bj][m][n].z * fmaxf((float)gq.z, 1e-4f), acc[ai][bj][m][n].w * fmaxf((float)gq.w, 1e-4f));
                        *(u32x2*)(MM + o) = w; } }
    }
};
struct EpiIn {
    static constexpr bool PERM = true, HOOK = false, AFTER_DRAIN = false;
    f16 *Q, *V, *SOG, *BG, *U, *SGA, *SGB; float* LF; const float* LB;
    __device__ __forceinline__ static bool paired(int pn) { return pn >= 20 && pn < 28; }
    template <int FN> __device__ __forceinline__ static void store_fn(const f32x4 (&acc)[2][2][4][2], f16* dst, int row0, int col0) {
#pragma unroll
        for (int ai = 0; ai < 2; ++ai)
#pragma unroll
            for (int m = 0; m < 4; ++m)
#pragma unroll
                for (int bj = 0; bj < 2; ++bj) {
                    float h[8];
#pragma unroll
                    for (int n = 0; n < 2; ++n)
#pragma unroll
                        for (int j = 0; j < 4; ++j) { const float x = acc[ai][bj][m][n][j]; float r = x;
                            if (FN != 0) { const float sg = sigmoidf_(x); r = (FN == 1) ? x * sg : sg; }
                            h[n * 4 + j] = r; }
                    u32x4 w; w.x = pkh(h[0], h[1]); w.y = pkh(h[2], h[3]); w.z = pkh(h[4], h[5]); w.w = pkh(h[6], h[7]);
                    *(u32x4*)(dst + (size_t)(row0 + ai * HALF + m * 16) * D + col0 + bj * HALF) = w;
                }
    }
    __device__ __forceinline__ void tail1(int row, int pn, int cc, const f32x4& v) const {
        const int cl = cc - 256 * pn;
        if (pn >= 4 && pn < 8) { const int col = (pn - 4) * 256 + cl; const f32x4 lb = *(const f32x4*)(LB + col); f32x4 r;
#pragma unroll
            for (int j = 0; j < 4; ++j) r[j] = lb[j] + (1.0f - lb[j]) * sigmoidf_(v[j]);
            *(f32x4*)(LF + (size_t)row * D + col) = r; return; }
        f16* dst; int fn, cbase;
        if (pn < 4) { dst = Q; fn = 1; cbase = pn * 256; }
        else if (pn < 12) { dst = V; fn = 0; cbase = (pn - 8) * 256; }
        else if (pn < 16) { dst = SOG; fn = 1; cbase = (pn - 12) * 256; }
        else if (pn < 20) { dst = BG; fn = 0; cbase = (pn - 16) * 256; }
        else if (pn < 32) { dst = SGA; fn = 2; cbase = (pn - 28) * 256; }
        else { dst = SGB; fn = 2; cbase = (pn - 32) * 256; }
        float h[4];
#pragma unroll
        for (int j = 0; j < 4; ++j) { const float x = v[j]; float r = x; if (fn != 0) { const float sg = sigmoidf_(x); r = (fn == 1) ? x * sg : sg; } h[j] = r; }
        u32x2 w; w.x = pkh(h[0], h[1]); w.y = pkh(h[2], h[3]); *(u32x2*)(dst + (size_t)row * D + cbase + cl) = w;
    }
    __device__ __forceinline__ void tail(int row, int pn, int cc0, int cc1, const f32x4& v0, const f32x4& v1) const {
        if (pn >= 20 && pn < 28) { u32x2 w; w.x = pkh(v0[0] * v1[0], v0[1] * v1[1]); w.y = pkh(v0[2] * v1[2], v0[3] * v1[3]);
            *(u32x2*)(U + (size_t)row * D + (pn - 20) * 128 + (cc0 - 256 * pn)) = w; return; }
        tail1(row, pn, cc0, v0); tail1(row, pn, cc1, v1);
    }
    __device__ __forceinline__ void operator()(const f32x4 (&acc)[2][2][4][2], const Unit& u, int wr, int wc, int fr, int fq) const {
        const int row0 = u.pm * BM + wr * 64 + fr, pn = u.pn;
        if (pn >= 20 && pn < 28) {
            const int col0 = (pn - 20) * 128 + wc * 32 + 8 * fq;
#pragma unroll
            for (int ai = 0; ai < 2; ++ai)
#pragma unroll
                for (int m = 0; m < 4; ++m) {
                    float h[8];
#pragma unroll
                    for (int n = 0; n < 2; ++n)
#pragma unroll
                        for (int j = 0; j < 4; ++j) h[n * 4 + j] = acc[ai][0][m][n][j] * acc[ai][1][m][n][j];
                    u32x4 w; w.x = pkh(h[0], h[1]); w.y = pkh(h[2], h[3]); w.z = pkh(h[4], h[5]); w.w = pkh(h[6], h[7]);
                    *(u32x4*)(U + (size_t)(row0 + ai * HALF + m * 16) * D + col0) = w;
                }
        } else if (pn >= 4 && pn < 8) {
            const int col0 = (pn - 4) * 256 + wc * 32 + 8 * fq;
#pragma unroll
            for (int bj = 0; bj < 2; ++bj) {
                const f32x4 lb0 = *(const f32x4*)(LB + col0 + bj * HALF), lb1 = *(const f32x4*)(LB + col0 + bj * HALF + 4);
#pragma unroll
                for (int ai = 0; ai < 2; ++ai)
#pragma unroll
                    for (int m = 0; m < 4; ++m) {
                        f32x4 r0, r1;
#pragma unroll
                        for (int j = 0; j < 4; ++j) { r0[j] = lb0[j] + (1.0f - lb0[j]) * sigmoidf_(acc[ai][bj][m][0][j]); r1[j] = lb1[j] + (1.0f - lb1[j]) * sigmoidf_(acc[ai][bj][m][1][j]); }
                        float* p = LF + (size_t)(row0 + ai * HALF + m * 16) * D + col0 + bj * HALF;
                        *(f32x4*)p = r0; *(f32x4*)(p + 4) = r1;
                    }
            }
        } else {
            f16* dst; int fn, cbase;
            if (pn < 4) { dst = Q; fn = 1; cbase = pn * 256; }
            else if (pn < 12) { dst = V; fn = 0; cbase = (pn - 8) * 256; }
            else if (pn < 16) { dst = SOG; fn = 1; cbase = (pn - 12) * 256; }
            else if (pn < 20) { dst = BG; fn = 0; cbase = (pn - 16) * 256; }
            else if (pn < 32) { dst = SGA; fn = 2; cbase = (pn - 28) * 256; }
            else { dst = SGB; fn = 2; cbase = (pn - 32) * 256; }
            const int col0 = cbase + wc * 32 + 8 * fq;
            if (fn == 0) store_fn<0>(acc, dst, row0, col0); else if (fn == 1) store_fn<1>(acc, dst, row0, col0); else store_fn<2>(acc, dst, row0, col0);
        }
    }
};

typedef const __attribute__((address_space(1))) f16x8* gf16x8p;
template <int NT, int KB, class Epi>
__device__ __forceinline__ void tail_gemm(const f16* A, const f16* Bt, int N, int K, int nmain, int G, int blk, const Epi& E, int wave_s) {
    const int tid = opaque_tid(wave_s), lane = tid & 63, fr = lane & 15, fq = lane >> 4;
    constexpr int RG = NTAIL / 128, UPT = 16 / NT;
    const int ntail = (N / 256) * UPT * RG;
    const int rem = nmain % G, nlight = G - rem;
    if (blk < rem) return;
    for (int u = blk - rem; u < ntail; u += nlight) {
        const int rg = u % RG, cg = u / RG, pn = cg / UPT, jj = cg % UPT;
        const bool pr = Epi::paired(pn);
        const int row = MAIN + 128 * rg + 16 * wave_s + fr;
        int cc[NT];
#pragma unroll
        for (int i = 0; i < NT; ++i) cc[i] = pr ? 256 * pn + 16 * (jj * (NT / 2) + (i >> 1)) + 128 * (i & 1) : 256 * pn + 16 * (jj * NT + i);
        gf16x8p ap = (gf16x8p)(A + (size_t)row * K + 8 * fq);
        gf16x8p bp[NT];
#pragma unroll
        for (int i = 0; i < NT; ++i) bp[i] = (gf16x8p)(Bt + (size_t)(cc[i] + fr) * K + 8 * fq);
        f32x4 acc[NT];
#pragma unroll
        for (int i = 0; i < NT; ++i) acc[i] = (f32x4){0.f, 0.f, 0.f, 0.f};
#pragma unroll 1
        for (int ks = 0; ks < K / 32; ks += KB) {
            f16x8 av[KB], xv[KB][NT];
#pragma unroll
            for (int k = 0; k < KB; ++k) { av[k] = ap[(ks + k) * 4];
#pragma unroll
                for (int i = 0; i < NT; ++i) xv[k][i] = bp[i][(ks + k) * 4]; }
            __builtin_amdgcn_sched_barrier(0);
#pragma unroll
            for (int k = 0; k < KB; ++k)
#pragma unroll
                for (int i = 0; i < NT; ++i) acc[i] = __builtin_amdgcn_mfma_f32_16x16x32_f16(xv[k][i], av[k], acc[i], 0, 0, 0);
            __builtin_amdgcn_sched_barrier(0);
        }
#pragma unroll
        for (int i = 0; i < NT; i += 2) E.tail(row, pn, cc[i] + 4 * fq, cc[i + 1] + 4 * fq, acc[i], acc[i + 1]);
    }
}

template <class Epi>
__device__ __forceinline__ void tail_gemm_lds(LAS unsigned char* lds, const f16* A, const f16* Bt, int N, int K, int G, int blk, const Epi& E, int wave_s) {
    const int tid = opaque_tid(wave_s), lane = tid & 63, fr = lane & 15, fq = lane >> 4;
    constexpr int RS = 272, BUF = 160 * RS, RG = NTAIL / 128;
    const int ntail = (N / 32) * RG, nb = K / 128;
    typedef const __attribute__((address_space(1))) u32x4* gu4p;
    for (int u = blk; u < ntail; u += G) {
        const int rg = u % RG, cg = u / RG, c0 = 32 * cg, row0 = MAIN + 128 * rg;
        gu4p ga[4]; unsigned la[4];
#pragma unroll
        for (int i = 0; i < 4; ++i) { const int idx = tid + 512 * i, r = idx >> 4, ch = idx & 15; ga[i] = (gu4p)(A + (size_t)(row0 + r) * K + 8 * ch); la[i] = (unsigned)(r * RS + 16 * ch); }
        const int rb = tid >> 4, chb = tid & 15;
        gu4p gb = (gu4p)(Bt + (size_t)(c0 + rb) * K + 8 * chb); const unsigned lb = (unsigned)((128 + rb) * RS + 16 * chb);
        u32x4 ra[4], rbv;
#pragma unroll
        for (int i = 0; i < 4; ++i) ra[i] = ga[i][0];
        rbv = gb[0];
        f32x4 acc0 = {0.f, 0.f, 0.f, 0.f}, acc1 = acc0;
        const unsigned aoff = (unsigned)((16 * wave_s + fr) * RS + 16 * fq), boff0 = (unsigned)((128 + fr) * RS + 16 * fq), boff1 = (unsigned)((144 + fr) * RS + 16 * fq);
#pragma unroll 1
        for (int kb = 0; kb < nb; ++kb) {
            LAS unsigned char* buf = lds + (kb & 1) * BUF;
            if constexpr (Epi::HOOK) { if (kb == (nb >> 1)) E.tail_hook(row0 + 16 * wave_s + fr, c0 + 4 * fq, c0 + 16 + 4 * fq, acc0, acc1); }
#pragma unroll
            for (int i = 0; i < 4; ++i) *(LAS u32x4*)(buf + la[i]) = ra[i];
            *(LAS u32x4*)(buf + lb) = rbv;
            if (kb + 1 < nb) {
#pragma unroll
                for (int i = 0; i < 4; ++i) ra[i] = ga[i][(kb + 1) * 16];
                rbv = gb[(kb + 1) * 16]; }
            __syncthreads();
#pragma unroll
            for (int ks = 0; ks < 4; ++ks) { const f16x8 av = *(const LAS f16x8*)(buf + aoff + 64 * ks), x0 = *(const LAS f16x8*)(buf + boff0 + 64 * ks), x1 = *(const LAS f16x8*)(buf + boff1 + 64 * ks);
                acc0 = __builtin_amdgcn_mfma_f32_16x16x32_f16(x0, av, acc0, 0, 0, 0); acc1 = __builtin_amdgcn_mfma_f32_16x16x32_f16(x1, av, acc1, 0, 0, 0); }
        }
        if constexpr (Epi::AFTER_DRAIN) E.tail_fused(rg, cg, wave_s, fr, fq, acc0, acc1, tid); else E.tail(row0 + 16 * wave_s + fr, c0 >> 8, c0 + 4 * fq, c0 + 16 + 4 * fq, acc0, acc1);
    }
    __syncthreads();
}
}

struct Args {
    const float *x_prompt, *x_sample, *state_hgrn, *state_conv, *meta, *w_in, *lb_logits, *norm_w, *conv_w, *w_a, *w_b, *w_o, *gu1, *dn1, *gu2, *dn2, *ln_g, *ln_b;
    float* out; unsigned char* ws;
};

__device__ __forceinline__ float wave_sum(float v) {
#pragma unroll
    for (int o = 1; o < 64; o <<= 1) v += __shfl_xor(v, o);
    return v;
}

__device__ __forceinline__ void p0_transpose_item(const float* W, int K, int N, f16* WT, int ldk, int koff, int dst_row0, LAS float* scr, int k0, int n0, int lane) {
#pragma unroll 8
    for (int i = 0; i < 32; ++i) { const int kk = 2 * i + (lane >> 5); scr[kk * 33 + (lane & 31)] = W[(size_t)(k0 + kk) * N + n0 + (lane & 31)]; }
    LDS_WAIT(); asm volatile("" ::: "memory");
    const int c = lane & 7;
#pragma unroll
    for (int j = 0; j < 4; ++j) { const int n = (lane >> 3) + 8 * j; const LAS float* s = scr + (8 * c) * 33 + n;
        u32x4 o; o.x = pkh(s[0 * 33], s[1 * 33]); o.y = pkh(s[2 * 33], s[3 * 33]); o.z = pkh(s[4 * 33], s[5 * 33]); o.w = pkh(s[6 * 33], s[7 * 33]);
        *(u32x4*)(WT + (size_t)(dst_row0 + n) * ldk + koff + k0 + 8 * c) = o; }
    LDS_WAIT(); asm volatile("" ::: "memory");
}

__device__ __forceinline__ int gu_dst_row(int c) { int j = c, o = 0; if (c >= DFF) { j = c - DFF; o = 128; } return 256 * (j >> 7) + o + (j & 127); }
__device__ __forceinline__ int in_dst_row(int c) { const int seg = c >> 10; if (seg == 5) { const int j = c - 5120; return 5120 + 256 * (j >> 7) + (j & 127); }
    if (seg == 6) { const int j = c - 6144; return 5120 + 256 * (j >> 7) + 128 + (j & 127); } return c; }

__device__ __forceinline__ void p0_prologue(const Args& a, LAS unsigned char* lds, int blk, int G, int wave_s) {
    const int tid = opaque_tid(wave_s), lane = tid & 63, wave = __builtin_amdgcn_readfirstlane(tid >> 6);
    LAS float* scr = (LAS float*)(lds + wave * 16384);
    const int gw = blk * 8 + wave, NGW = G * 8;
    f16* WB = (f16*)(a.ws + WS_W);
    constexpr int I_GU = 16 * 176, I_DN = 44 * 32, I_IN = 16 * 288, I_SQ = 16 * 32, I_LAYER = 2 * I_GU + 2 * I_DN + I_IN + 3 * I_SQ;
    for (int it = gw; it < I_LAYER * NLAYER; it += NGW) {
        const int l = it / I_LAYER; int r = it % I_LAYER;
        f16* wl = WB + (size_t)l * W_LAYER;
        const float* W; int K, N, type; f16* WT; int ldk = 0, koff = 0;
        if (r < I_GU) { W = a.gu1 + (size_t)l * D * 2 * DFF; K = D; N = 2 * DFF; WT = wl + W_GU1; type = 1; }
        else if ((r -= I_GU) < I_DN) { W = a.dn1 + (size_t)l * DFF * D; K = DFF; N = D; WT = wl + W_DN1; type = 0; }
        else if ((r -= I_DN) < I_IN) { W = a.w_in + (size_t)l * D * NIN; K = D; N = NIN; WT = wl + W_IN; type = 2; }
        else if ((r -= I_IN) < I_SQ) { W = a.w_a + (size_t)l * D * D; K = D; N = D; WT = wl + W_A; type = 0; ldk = 2 * D; }
        else if ((r -= I_SQ) < I_SQ) { W = a.w_b + (size_t)l * D * D; K = D; N = D; WT = wl + W_A; type = 0; ldk = 2 * D; koff = D; }
        else if ((r -= I_SQ) < I_SQ) { W = a.w_o + (size_t)l * D * D; K = D; N = D; WT = wl + W_O; type = 0; }
        else if ((r -= I_SQ) < I_GU) { W = a.gu2 + (size_t)l * D * 2 * DFF; K = D; N = 2 * DFF; WT = wl + W_GU2; type = 1; }
        else { r -= I_GU; W = a.dn2 + (size_t)l * DFF * D; K = DFF; N = D; WT = wl + W_DN2; type = 0; }
        const int nblk = N / 32, kb = r / nblk, nb = r % nblk, n0 = nb * 32;
        const int drow = type == 1 ? gu_dst_row(n0) : type == 2 ? in_dst_row(n0) : n0;
        p0_transpose_item(W, K, N, WT, ldk ? ldk : K, koff, drow, scr, kb * 64, n0, lane);
    }
    float* X = (float*)(a.ws + WS_X); f16* XH = (f16*)(a.ws + WS_XH);
    for (int m = MROWS + gw; m < MPAD; m += NGW) {
#pragma unroll
        for (int j = 0; j < 4; ++j) *(u32x2*)(XH + (size_t)m * D + 256 * j + 4 * lane) = (u32x2){0u, 0u};
    }
    for (int m = gw; m < MROWS; m += NGW) {
        const float* src;
        if (m < MAIN) src = a.x_prompt + (size_t)m * D;
        else if (m < SAMP0) src = a.meta + (size_t)((m - META0) & 15) * D;
        else src = a.x_sample + (size_t)(m - SAMP0) * D;
#pragma unroll
        for (int j = 0; j < 4; ++j) { const f32x4 v = *(const f32x4*)(src + 256 * j + 4 * lane);
            u32x2 w; w.x = pkh(v.x, v.y); w.y = pkh(v.z, v.w); *(u32x2*)(XH + (size_t)m * D + 256 * j + 4 * lane) = w; }
    }
    if (blk == 0) {
        float* LB = (float*)(a.ws + WS_LB);
        for (int c = tid; c < D; c += 512) {
            float e[NLAYER], mx = -1e30f, s = 0.f;
            for (int l = 0; l < NLAYER; ++l) { e[l] = a.lb_logits[l * D + c]; mx = fmaxf(mx, e[l]); }
            for (int l = 0; l < NLAYER; ++l) { e[l] = expf(e[l] - mx); s += e[l]; }
            float cum = 0.f;
            LB[c] = 0.f;
            for (int l = 1; l < NLAYER; ++l) { cum += e[l]; LB[l * D + c] = cum / s; }
        }
    }
}

__device__ __forceinline__ void ln_phase(unsigned char* ws, float* out, const float* g, const float* bta, int blk, int G, bool final_, int wave_s) {
    const int tid = opaque_tid(wave_s), lane = tid & 63, wave = tid >> 6;
    const int gw = blk * 8 + wave, NGW = G * 8;
    const f16* X = (const f16*)(ws + WS_X); f16* XH = (f16*)(ws + WS_XH);
    f32x4 gv[4], bv[4];
#pragma unroll
    for (int j = 0; j < 4; ++j) { gv[j] = *(const f32x4*)(g + 256 * j + 4 * lane); bv[j] = *(const f32x4*)(bta + 256 * j + 4 * lane); }
    for (int m = gw; m < MROWS; m += NGW) {
        const f16* xr = X + (size_t)m * D + 4 * lane;
        f32x4 v[4]; float s = 0.f;
#pragma unroll
        for (int j = 0; j < 4; ++j) { const f16x4 hx = *(const f16x4*)(xr + 256 * j); v[j] = (f32x4){(float)hx.x, (float)hx.y, (float)hx.z, (float)hx.w}; s += (v[j].x + v[j].y) + (v[j].z + v[j].w); }
        const float mean = wave_sum(s) * (1.f / D); float s2 = 0.f;
#pragma unroll
        for (int j = 0; j < 4; ++j) { v[j] = v[j] - mean; s2 += (v[j].x * v[j].x + v[j].y * v[j].y) + (v[j].z * v[j].z + v[j].w * v[j].w); }
        const float rstd = 1.0f / sqrtf(wave_sum(s2) * (1.f / D) + LN_EPS);
        if (!final_) {
#pragma unroll
            for (int j = 0; j < 4; ++j) { const f32x4 y = v[j] * rstd * gv[j] + bv[j];
                u32x2 w; w.x = pkh(y.x, y.y); w.y = pkh(y.z, y.w); *(u32x2*)(XH + (size_t)m * D + 256 * j + 4 * lane) = w; }
        } else {
            float* dst = nullptr;
            if (m < MAIN) dst = out + O_YP + (size_t)m * D;
            else if (m >= SAMP0) dst = out + O_YS + (size_t)(m - SAMP0) * D;
            if (dst) {
#pragma unroll
                for (int j = 0; j < 4; ++j) { const f32x4 y = v[j] * rstd * gv[j] + bv[j]; *(f32x4*)(dst + 256 * j + 4 * lane) = y; }
            }
        }
    }
}

constexpr int H_SH = 0, SH_STRIDE = 272, SH_SZ = 32 * SH_STRIDE, H_P = 4 * SH_SZ, P_STRIDE = 48;
constexpr int QS_STRIDE = 272, KT_STRIDE = 144;
constexpr int VT_SZ = 32 * KT_STRIDE, QH_SZ = 64 * QS_STRIDE;
constexpr int H_VT0 = H_P + 64 * P_STRIDE, H_QH0 = H_VT0 + 2 * VT_SZ;
constexpr int H_QB = H_QH0 + 2 * QH_SZ, H_KO = H_QB + 64 * QS_STRIDE, H_KT = H_KO + 64 * QS_STRIDE, H_ES = H_KT + 128 * KT_STRIDE, H_END = H_ES + 2048;
static_assert(H_END <= XB_LDS_OFF && (H_VT0 % 16) == 0 && (H_QH0 % 16) == 0 && (H_QB % 16) == 0 && (H_KT % 16) == 0 && (H_ES % 16) == 0, "hgrn lds map");

__device__ __forceinline__ void hgrn_prompt_item(unsigned char* ws, float* out, LAS unsigned char* lds, int l, int item, int wave_s) {
    const int tid = opaque_tid(wave_s), lane = tid & 63, wave = __builtin_amdgcn_readfirstlane(tid >> 6), fr = lane & 15, fq = lane >> 4;
    const int bh = item >> 2, dvs = item & 3, b = bh >> 3, h = bh & 7;
    const f16* Q = (const f16*)(ws + WS_Q); const float* LF = (const float*)(ws + WS_LF); const f16* V = (const f16*)(ws + WS_V);
    f16* OR = (f16*)(ws + WS_MM); float* SS = (float*)(ws + WS_SS);
    const size_t rowb = (size_t)b * SEQP, rowm = (size_t)META0 + (size_t)b * NMETA;
    f32x4 S[2] = {{0.f, 0.f, 0.f, 0.f}, {0.f, 0.f, 0.f, 0.f}};
    const int ti = wave >> 1, hh = lane >> 5, dp = 32 * (wave & 1) + (lane & 31), tt0 = 16 * ti + 8 * hh;
    f32x2 pF[8]; unsigned pQ2[8]; u32x4 pV;
#define HG_LOAD(c) do { const size_t _rb = (c) == 0 ? rowm : rowb + 64 * ((c) - 1); const int _L = (c) == 0 ? 16 : 64; \
        _Pragma("unroll") for (int k = 0; k < 8; ++k) { pF[k] = (f32x2){1.f, 1.f}; pQ2[k] = 0u; \
            if (tt0 + k < _L) { pF[k] = *(const f32x2*)(LF + (_rb + tt0 + k) * D + 128 * h + 2 * dp); pQ2[k] = *(const unsigned*)(Q + (_rb + tt0 + k) * D + 128 * h + 2 * dp); } } \
        { const int r = tid >> 2, cc = tid & 3; pV = (u32x4){0u, 0u, 0u, 0u}; if (r < _L) pV = *(const u32x4*)(V + (_rb + r) * D + 128 * h + 32 * dvs + 8 * cc); } } while (0)
    HG_LOAD(0);
    constexpr int NCH = 33;
    for (int c = 0; c < NCH; ++c) {
        const size_t rbase = c == 0 ? rowm : rowb + 64 * (c - 1); const int L = c == 0 ? 16 : 64;
        const int H_VT = H_VT0 + (c & 1) * VT_SZ, H_QH = H_QH0 + (c & 1) * QH_SZ;
        if (tid < 256) { const int r = tid >> 2, cc = tid & 3;
#pragma unroll
            for (int e = 0; e < 4; ++e) { const unsigned w = pV[e]; *(LAS unsigned short*)(lds + H_VT + (8 * cc + 2 * e) * KT_STRIDE + 2 * r) = (unsigned short)(w & 0xffffu);
                *(LAS unsigned short*)(lds + H_VT + (8 * cc + 2 * e + 1) * KT_STRIDE + 2 * r) = (unsigned short)(w >> 16); } }
        {
            f32x2 eb[8]; f32x2 run = {1.f, 1.f};
#pragma unroll
            for (int k = 0; k < 8; ++k) { run = run * pF[k]; eb[k] = run; }
            f32x2 oth; oth.x = __shfl_xor(run.x, 32); oth.y = __shfl_xor(run.y, 32);
            const f32x2 bc = run * oth;
            const f32x2 pre = hh ? oth : (f32x2){1.f, 1.f};
            unsigned kt0[4], kt1[4];
#pragma unroll
            for (int k = 0; k < 8; ++k) {
                const f32x2 e = eb[k] * pre; const f16x2 qh2 = __builtin_bit_cast(f16x2, pQ2[k]);
                const f32x2 q = {(float)qh2.x, (float)qh2.y}, kk = (f32x2){1.f, 1.f} - pF[k];
                f32x2 inv; inv.x = __builtin_amdgcn_rcpf(fmaxf(e.x, 1e-30f)); inv.y = __builtin_amdgcn_rcpf(fmaxf(e.y, 1e-30f));
                const f32x2 qh = q * e, ko = kk * inv, ke = ko * bc;
                const int trow = (tt0 + k) * QS_STRIDE + dp * 4;
                *(LAS unsigned*)(lds + H_QH + trow) = pkh(qh.x, qh.y);
                *(LAS unsigned*)(lds + H_QB + trow) = pkb(qh.x, qh.y);
                *(LAS unsigned*)(lds + H_KO + trow) = pkb(ko.x, ko.y);
                const unsigned short h0 = __builtin_bit_cast(unsigned short, (f16)ke.x), h1 = __builtin_bit_cast(unsigned short, (f16)ke.y);
                if (k & 1) { kt0[k >> 1] |= (unsigned)h0 << 16; kt1[k >> 1] |= (unsigned)h1 << 16; } else { kt0[k >> 1] = h0; kt1[k >> 1] = h1; }
            }
            *(LAS u32x4*)(lds + H_KT + (2 * dp) * KT_STRIDE + 2 * tt0) = (u32x4){kt0[0], kt0[1], kt0[2], kt0[3]};
            *(LAS u32x4*)(lds + H_KT + (2 * dp + 1) * KT_STRIDE + 2 * tt0) = (u32x4){kt1[0], kt1[1], kt1[2], kt1[3]};
            if (hh == 0) *(LAS f32x2*)(lds + H_ES + (ti * 128 + 2 * dp) * 4) = bc;
        }
        if (c + 1 < NCH) HG_LOAD(c + 1);
        __syncthreads();
        if (wave < 4) {
            const int i = wave; f32x4 p = {0.f, 0.f, 0.f, 0.f};
#pragma unroll
            for (int ks = 0; ks < 4; ++ks) { const s16x8 qa = *(const LAS s16x8*)(lds + H_QB + (16 * i + fr) * QS_STRIDE + 64 * ks + 16 * fq);
                const s16x8 kb = *(const LAS s16x8*)(lds + H_KO + (16 * i + fr) * QS_STRIDE + 64 * ks + 16 * fq);
                p = __builtin_amdgcn_mfma_f32_16x16x32_bf16(kb, qa, p, 0, 0, 0); }
            u32x2 w; w.x = pkh((4 * fq + 0 <= fr) ? p[0] : 0.f, (4 * fq + 1 <= fr) ? p[1] : 0.f); w.y = pkh((4 * fq + 2 <= fr) ? p[2] : 0.f, (4 * fq + 3 <= fr) ? p[3] : 0.f);
            *(LAS u32x2*)(lds + H_P + (16 * i + fr) * P_STRIDE + 8 * fq) = w;
        }
        {
            const int dd = 16 * wave + fr, d4 = 16 * wave + 4 * fq;
#pragma unroll
            for (int i = 0; i < 4; ++i) {
#pragma unroll
                for (int vt = 0; vt < 2; ++vt) { u32x2 w; w.x = pkh(S[vt][0], S[vt][1]); w.y = pkh(S[vt][2], S[vt][3]);
                    *(LAS u32x2*)(lds + H_SH + i * SH_SZ + (16 * vt + fr) * SH_STRIDE + d4 * 2) = w; }
                const f32x4 sc = *(const LAS f32x4*)(lds + H_ES + (i * 128 + d4) * 4);
                f16x8 kb = {0, 0, 0, 0, 0, 0, 0, 0}, va0 = kb, va1 = kb;
                if (fq < 2) { kb = *(const LAS f16x8*)(lds + H_KT + dd * KT_STRIDE + 32 * i + 16 * fq);
                    va0 = *(const LAS f16x8*)(lds + H_VT + fr * KT_STRIDE + 32 * i + 16 * fq); va1 = *(const LAS f16x8*)(lds + H_VT + (16 + fr) * KT_STRIDE + 32 * i + 16 * fq); }
                S[0] = S[0] * sc; S[1] = S[1] * sc;
                S[0] = __builtin_amdgcn_mfma_f32_16x16x32_f16(kb, va0, S[0], 0, 0, 0);
                S[1] = __builtin_amdgcn_mfma_f32_16x16x32_f16(kb, va1, S[1], 0, 0, 0);
            }
        }
        __syncthreads();
        {
            const int i = wave >> 1, vt = wave & 1; f32x4 o = {0.f, 0.f, 0.f, 0.f};
            f16x8 pa = {0, 0, 0, 0, 0, 0, 0, 0}, vb = pa;
            if (fq < 2) { pa = *(const LAS f16x8*)(lds + H_P + (16 * i + fr) * P_STRIDE + 16 * fq); vb = *(const LAS f16x8*)(lds + H_VT + (16 * vt + fr) * KT_STRIDE + 32 * i + 16 * fq); }
            o = __builtin_amdgcn_mfma_f32_16x16x32_f16(vb, pa, o, 0, 0, 0);
#pragma unroll
            for (int ks = 0; ks < 4; ++ks) { const f16x8 qa = *(const LAS f16x8*)(lds + H_QH + (16 * i + fr) * QS_STRIDE + 64 * ks + 16 * fq);
                const f16x8 sb = *(const LAS f16x8*)(lds + H_SH + i * SH_SZ + (16 * vt + fr) * SH_STRIDE + 64 * ks + 16 * fq);
                o = __builtin_amdgcn_mfma_f32_16x16x32_f16(sb, qa, o, 0, 0, 0); }
            float sq = (o[0] * o[0] + o[1] * o[1]) + (o[2] * o[2] + o[3] * o[3]);
            sq += __shfl_xor(sq, 16); sq += __shfl_xor(sq, 32);
            const int t = 16 * i + fr;
            if (t < L) { const size_t row = rbase + t; u32x2 w; w.x = pkh(o[0], o[1]); w.y = pkh(o[2], o[3]);
                *(u32x2*)(OR + row * D + 128 * h + 32 * dvs + 16 * vt + 4 * fq) = w; if (fq == 0) SS[row * 64 + h * 8 + dvs * 2 + vt] = sq; }
        }
    }
#undef HG_LOAD
    __syncthreads();
    float* outS = out + O_HP + ((((size_t)l * BP + b) * NH + h) * DK + (16 * wave + 4 * fq)) * DV + 32 * dvs + fr;
#pragma unroll
    for (int j = 0; j < 4; ++j) { outS[(size_t)j * DV] = S[0][j]; outS[(size_t)j * DV + 16] = S[1][j]; }
}

__device__ __forceinline__ void hgrn_sample_item(unsigned char* ws, float* out, const float* state_hgrn, LAS unsigned char* lds, int l, int item, int wave_s) {
    const int tid = opaque_tid(wave_s), lane = tid & 63;
    const int bs = item >> 3, h = item & 7;
    const f16* Q = (const f16*)(ws + WS_Q); const float* LF = (const float*)(ws + WS_LF); const f16* V = (const f16*)(ws + WS_V);
    f16* OR = (f16*)(ws + WS_MM); float* SS = (float*)(ws + WS_SS);
    LAS float* sq = (LAS float*)lds; LAS float* sf = sq + 512; LAS float* sk = sf + 512; LAS float* sv = sk + 512; LAS float* red = sv + 512;
    const size_t row0 = (size_t)SAMP0 + (size_t)bs * TS;
    { const int t = tid >> 7, d = tid & 127; const size_t o = (row0 + t) * D + 128 * h + d; const float f = LF[o];
      sq[tid] = (float)Q[o]; sf[tid] = f; sk[tid] = 1.0f - f; sv[tid] = (float)V[o]; }
    const int vq = tid & 31, dg = tid >> 5;
    const size_t sbase = ((((size_t)l * BS + bs) * NH + h) * DK + 8 * dg) * DV + 4 * vq;
    f32x4 S[8];
#pragma unroll
    for (int dd = 0; dd < 8; ++dd) S[dd] = *(const f32x4*)(state_hgrn + sbase + (size_t)dd * DV);
    __syncthreads();
#pragma unroll
    for (int t = 0; t < TS; ++t) {
        const f32x4 vv = *(const LAS f32x4*)(sv + t * 128 + 4 * vq); f32x4 po = {0.f, 0.f, 0.f, 0.f};
#pragma unroll
        for (int dd = 0; dd < 8; ++dd) { const int d = t * 128 + 8 * dg + dd; const float f = sf[d], k = sk[d], q = sq[d]; S[dd] = S[dd] * f + vv * k; po += S[dd] * q; }
        *(LAS f32x4*)(red + (t * 16 + dg) * 128 + 4 * vq) = po;
    }
    __syncthreads();
    { const int t = tid >> 7, v = tid & 127; float o = 0.f;
#pragma unroll
      for (int g = 0; g < 16; ++g) o += red[(t * 16 + g) * 128 + v];
      const size_t row = row0 + t; OR[row * D + 128 * h + v] = (f16)o;
      const float s = wave_sum(o * o);
      if (lane < 4) SS[row * 64 + h * 8 + ((tid >> 6) & 1) * 4 + lane] = lane == 0 ? s : 0.f; }
    float* outS = out + O_HS + sbase;
#pragma unroll
    for (int dd = 0; dd < 8; ++dd) *(f32x4*)(outS + (size_t)dd * DV) = S[dd];
    __syncthreads();
}

__device__ __forceinline__ void mix_post_phase(unsigned char* ws, float* out, const float* norm_w, const float* conv_w, const float* state_conv, int l, int blk, int G, int wave_s) {
    const int tid = opaque_tid(wave_s);
    const f16* O = (const f16*)(ws + WS_MM); const float* SS = (const float*)(ws + WS_SS); const f16* SOG = (const f16*)(ws + WS_SOG);
    const f16* BG = (const f16*)(ws + WS_BG); const f16* U = (const f16*)(ws + WS_U); f16* AB = (f16*)(ws + WS_O);
    const float* nw = norm_w + (size_t)l * DV; const float* cw = conv_w + (size_t)l * 3 * D;
    for (int idx = blk * 512 + tid; idx < MROWS * 128; idx += G * 512) {
        const int row = idx >> 7, c8 = idx & 127, col = 8 * c8, head = c8 >> 4;
        const size_t o = (size_t)row * D + col;
        const f32x4 s0 = *(const f32x4*)(SS + (size_t)row * 64 + head * 8), s1 = *(const f32x4*)(SS + (size_t)row * 64 + head * 8 + 4);
        const float ms = ((s0.x + s0.y) + (s0.z + s0.w) + (s1.x + s1.y) + (s1.z + s1.w)) * (1.f / DV);
        const float r = 1.0f / sqrtf(ms + RMS_EPS);
        const f16x8 ov = *(const f16x8*)(O + o), gv = *(const f16x8*)(SOG + o);
        const f32x4 w0 = *(const f32x4*)(nw + (col & 127)), w1 = *(const f32x4*)(nw + (col & 127) + 4);
        float res[8];
#pragma unroll
        for (int e = 0; e < 8; ++e) res[e] = (float)ov[e] * r * (e < 4 ? w0[e] : w1[e - 4]) * (float)gv[e];
        u32x4 w; w.x = pkh(res[0], res[1]); w.y = pkh(res[2], res[3]); w.z = pkh(res[4], res[5]); w.w = pkh(res[6], res[7]);
        *(u32x4*)(AB + (size_t)row * 2 * D + col) = w;
        int t, T; const float* buf = nullptr; float* nb = nullptr; size_t o1 = o - D, o2 = o - 2 * D;
        if (row < MAIN) { const int b = row >> 11, tp = row & 2047; t = tp + NMETA; T = TP; nb = out + O_CP + ((size_t)l * BP + b) * 2 * D;
            if (tp < 1) o1 = (size_t)(META0 + b * NMETA + 15) * D + col;
            if (tp < 2) o2 = (size_t)(META0 + b * NMETA + 14 + tp) * D + col; }
        else if (row < SAMP0) { t = (row - META0) & 15; T = TP; }
        else { const int bs = (row - SAMP0) >> 2; t = (row - SAMP0) & 3; T = TS; buf = state_conv + ((size_t)l * BS + bs) * 2 * D; nb = out + O_CS + ((size_t)l * BS + bs) * 2 * D; }
        const f16x8 u2 = *(const f16x8*)(U + o);
        float um1[8], um2[8];
#pragma unroll
        for (int e = 0; e < 8; ++e) { um1[e] = 0.f; um2[e] = 0.f; }
        if (t >= 1) { const f16x8 x = *(const f16x8*)(U + o1);
#pragma unroll
            for (int e = 0; e < 8; ++e) um1[e] = (float)x[e]; }
        else if (buf) {
#pragma unroll
            for (int e = 0; e < 8; ++e) um1[e] = buf[D + col + e]; }
        if (t >= 2) { const f16x8 x = *(const f16x8*)(U + o2);
#pragma unroll
            for (int e = 0; e < 8; ++e) um2[e] = (float)x[e]; }
        else if (buf) {
#pragma unroll
            for (int e = 0; e < 8; ++e) um2[e] = buf[(size_t)t * D + col + e]; }
        const f16x8 bg = *(const f16x8*)(BG + o);
        float cr[8];
#pragma unroll
        for (int e = 0; e < 8; ++e) cr[e] = (float)bg[e] * (cw[col + e] * um2[e] + cw[D + col + e] * um1[e] + cw[2 * D + col + e] * (float)u2[e]);
        u32x4 cwv; cwv.x = pkh(cr[0], cr[1]); cwv.y = pkh(cr[2], cr[3]); cwv.z = pkh(cr[4], cr[5]); cwv.w = pkh(cr[6], cr[7]);
        *(u32x4*)(AB + (size_t)row * 2 * D + D + col) = cwv;
        if (t >= T - 2 && nb) { float* p = nb + (size_t)(t - (T - 2)) * D + col;
#pragma unroll
            for (int e = 0; e < 8; ++e) p[e] = (float)u2[e]; }
    }
}

#define XB_TMO      128
#define XB_XCNT(j)  (256  + 64 * (j))
#define XB_XSUB(j)  (1280 + 64 * (j))
#define XB_XGEN(j)  (2304 + 64 * (j))
#define XB_TOP      3328
#define XB_TOPGEN   3392
#define XCD_BAR_WORDS 3456
#define XB_SPIN_CAP (1u << 18)
__device__ __forceinline__ unsigned xb_ld(unsigned* p)              { return __hip_atomic_load(p, __ATOMIC_RELAXED, __HIP_MEMORY_SCOPE_AGENT); }
__device__ __forceinline__ unsigned xb_add(unsigned* p, unsigned v) { return __hip_atomic_fetch_add(p, v, __ATOMIC_RELAXED, __HIP_MEMORY_SCOPE_AGENT); }
__device__ __forceinline__ unsigned xb_xcc_id() { return (unsigned)__builtin_amdgcn_s_getreg((3 << 11) | 20) & 0xFu; }
#define XB_SPIN(cond, bar) do { unsigned _sp = 0; while (cond) { __builtin_amdgcn_s_sleep(1); \
    if ((++_sp & 255u) == 0u) { if (xb_ld(&(bar)[XB_TMO])) break; if (_sp > XB_SPIN_CAP) { atomicAdd(&(bar)[XB_TMO], 1u); break; } } } } while (0)
struct XcdBarrier { unsigned* bar; unsigned x; volatile LAS unsigned* st; };
__device__ __forceinline__ void xcd_barrier_complete(unsigned* bar, unsigned x, unsigned& nloc, unsigned& nx) {
    const unsigned G = gridDim.x * gridDim.y * gridDim.z;
    unsigned sum, cnt, mine, sp = 0u;
    for (;;) {
        sum = 0u; cnt = 0u; mine = 0u;
#pragma unroll
        for (unsigned j = 0; j < 16; ++j) { const unsigned c = xb_ld(&bar[XB_XCNT(j)]); sum += c; cnt += (c > 0u) ? 1u : 0u; mine = (j == x) ? c : mine; }
        if (sum == G) break;
        __builtin_amdgcn_s_sleep(1);
        if ((++sp & 255u) == 0u) { if (xb_ld(&bar[XB_TMO])) break; if (sp > XB_SPIN_CAP) { atomicAdd(&bar[XB_TMO], 1u); break; } }
    }
    nloc = mine > 0u ? mine : 1u; nx = cnt > 0u ? cnt : 1u;
}
__device__ __forceinline__ void xcd_barrier(const XcdBarrier& b, int tid) {
    asm volatile("s_waitcnt vmcnt(0)" ::: "memory");
    __syncthreads();
    if (tid == 0) {
        unsigned* bar = b.bar;
        __builtin_amdgcn_s_waitcnt(0);
        unsigned nloc = b.st[0], nx = b.st[1];
        if (nloc == 0u) { xcd_barrier_complete(bar, b.x, nloc, nx); b.st[0] = nloc; b.st[1] = nx; }
        const unsigned old = xb_add(&bar[XB_XSUB(b.x)], 1u);
        const unsigned gen = old / nloc;
        if (old + 1u == (gen + 1u) * nloc) {
            __builtin_amdgcn_fence(__ATOMIC_RELEASE, "agent");
            asm volatile("s_waitcnt vmcnt(0)" ::: "memory");
            const unsigned og = xb_add(&bar[XB_TOP], 1u);
            const unsigned tg = og / nx;
            if (og + 1u == (tg + 1u) * nx) xb_add(&bar[XB_TOPGEN], 1u);
            else XB_SPIN(xb_ld(&bar[XB_TOPGEN]) == tg, bar);
            __builtin_amdgcn_fence(__ATOMIC_ACQUIRE, "agent");
            xb_add(&bar[XB_XGEN(b.x)], 1u);
            asm volatile("s_waitcnt vmcnt(0)" ::: "memory");
        } else {
            XB_SPIN(xb_ld(&bar[XB_XGEN(b.x)]) == gen, bar);
            __builtin_amdgcn_fence(__ATOMIC_ACQUIRE, "agent");
            asm volatile("s_waitcnt vmcnt(0)" ::: "memory");
        }
    }
    __syncthreads();
}

__global__ void __launch_bounds__(512, 2) mega_fwd(Args a) {
    extern __shared__ __attribute__((aligned(16))) unsigned char lds_raw[];
    LAS unsigned char* lds = (LAS unsigned char*)lds_raw;
#define WSP() karg<19>()
#define LDSP() ({ LAS unsigned char* _p = lds; asm volatile("" : "+s"(_p)); _p; })
    const int blk = blockIdx.x, G = gridDim.x;
    const int vcu = (G % 8 == 0) ? (blk % 8) * (G / 8) + blk / 8 : blk;
    const int wave_s = __builtin_amdgcn_readfirstlane((int)threadIdx.x >> 6);
    volatile LAS unsigned* xst = (volatile LAS unsigned*)(lds + XB_LDS_OFF);
    if (threadIdx.x < 4) xst[threadIdx.x] = 0u;
    __syncthreads();
    XcdBarrier xbar; xbar.bar = (unsigned*)(a.ws + WS_CTL) + 4096; xbar.x = xb_xcc_id(); xbar.st = xst;
    if (threadIdx.x == 0) (void)xb_add(&xbar.bar[XB_XCNT(xbar.x)], 1u);
#define GRID_BAR() do { XcdBarrier _xb; _xb.bar = (unsigned*)(karg<19>() + WS_CTL) + 4096; _xb.x = xb_xcc_id(); _xb.st = (volatile LAS unsigned*)(LDSP() + XB_LDS_OFF); xcd_barrier(_xb, opaque_tid(wave_s)); } while (0)
    p0_prologue(a, lds, vcu, G, wave_s);
    if (a.out == nullptr) { cg::grid_group grid = cg::this_grid(); grid.sync(); }
    GRID_BAR();
    for (int l = 0; l < NLAYER; ++l) {
#define WL() ((const f16*)(WSP() + WS_W) + (size_t)l * W_LAYER)
        pg8::StaticOrder S;
        { unsigned char* ws = WSP(); pg8::Gemm g{(const f16*)(ws + WS_XH), WL() + W_GU1, MPAD, 2 * DFF, D}; S.init(MPAD, 2 * DFF, opaque_s(G), opaque_s(blk)); pg8::EpiGU E{(f16*)(ws + WS_H)}; pg8::gemm_phase(LDSP(), g, S, E, wave_s); }
        GRID_BAR();
        { unsigned char* ws = WSP(); pg8::Gemm g{(const f16*)(ws + WS_H), WL() + W_DN1, MAIN, D, DFF}; S.init(MAIN, D, opaque_s(G), opaque_s(blk)); pg8::EpiResLN E{(const f16*)(ws + WS_XH), (f16*)(ws + WS_XH), ((float*)nullptr), 0.5f, (const float*)karg<16>() + (size_t)l * 3 * D + 0 * D, (const float*)karg<17>() + (size_t)l * 3 * D + 0 * D, ws + WS_X, (unsigned*)(ws + WS_CTL) + CW_PANEL, (unsigned)(l * 3 + 0) + 1u}; pg8::gemm_phase(LDSP(), g, S, E, wave_s);
          pg8::tail_gemm_lds(LDSP(), g.A, g.Bt, g.N, g.K, opaque_s(G), opaque_s(blk), E, wave_s); }
        GRID_BAR();
        { unsigned char* ws = WSP(); pg8::Gemm g{(const f16*)(ws + WS_XH), WL() + W_IN, MPAD, NIN, D}; S.init(MPAD, NIN, opaque_s(G), opaque_s(blk));
          pg8::EpiIn E{(f16*)(ws + WS_Q), (f16*)(ws + WS_V), (f16*)(ws + WS_SOG), (f16*)(ws + WS_BG), (f16*)(ws + WS_U), (f16*)(ws + WS_SGA), (f16*)(ws + WS_SGB),
                       (float*)(ws + WS_LF), (const float*)(ws + WS_LB) + (size_t)l * D};
          pg8::gemm_phase(LDSP(), g, S, E, wave_s); }
        GRID_BAR();
        {
            for (int it = blk; it < 256; it += G) { const int item = ((it & 7) * 8 + (it >> 5)) * 4 + ((it >> 3) & 3); hgrn_prompt_item(WSP(), (float*)karg<18>(), LDSP(), l, item, wave_s); }
            for (int it = blk; it < BS * NH; it += G) hgrn_sample_item(WSP(), (float*)karg<18>(), (const float*)karg<2>(), LDSP(), l, it, wave_s);
        }
        GRID_BAR();
        mix_post_phase(WSP(), (float*)karg<18>(), (const float*)karg<7>(), (const float*)karg<8>(), (const float*)karg<3>(), l, opaque_s(vcu), opaque_s(G), wave_s);
        GRID_BAR();
        { unsigned char* ws = WSP(); pg8::Gemm g{(const f16*)(ws + WS_O), WL() + W_A, MAIN, D, 2 * D}; S.init(MAIN, D, opaque_s(G), opaque_s(blk));
          pg8::EpiMerge E{(const f16*)(ws + WS_SGA), (const f16*)(ws + WS_SGB), (f16*)(ws + WS_MM)}; pg8::gemm_phase(LDSP(), g, S, E, wave_s);
          pg8::tail_gemm_lds(LDSP(), g.A, g.Bt, g.N, g.K, opaque_s(G), opaque_s(blk), E, wave_s); }
        GRID_BAR();
        { unsigned char* ws = WSP(); pg8::Gemm g{(const f16*)(ws + WS_MM), WL() + W_O, MAIN, D, D}; S.init(MAIN, D, opaque_s(G), opaque_s(blk)); pg8::EpiResLN E{(const f16*)(ws + WS_XH), (f16*)(ws + WS_XH), ((float*)nullptr), 1.0f, (const float*)karg<16>() + (size_t)l * 3 * D + 1 * D, (const float*)karg<17>() + (size_t)l * 3 * D + 1 * D, ws + WS_X, (unsigned*)(ws + WS_CTL) + CW_PANEL, (unsigned)(l * 3 + 1) + 1u}; pg8::gemm_phase(LDSP(), g, S, E, wave_s);
          pg8::tail_gemm_lds(LDSP(), g.A, g.Bt, g.N, g.K, opaque_s(G), opaque_s(blk), E, wave_s); }
        GRID_BAR();
        { unsigned char* ws = WSP(); pg8::Gemm g{(const f16*)(ws + WS_XH), WL() + W_GU2, MPAD, 2 * DFF, D}; S.init(MPAD, 2 * DFF, opaque_s(G), opaque_s(blk)); pg8::EpiGU E{(f16*)(ws + WS_H)}; pg8::gemm_phase(LDSP(), g, S, E, wave_s); }
        GRID_BAR();
        { unsigned char* ws = WSP(); pg8::Gemm g{(const f16*)(ws + WS_H), WL() + W_DN2, MAIN, D, DFF}; S.init(MAIN, D, opaque_s(G), opaque_s(blk)); pg8::EpiResLN E{(const f16*)(ws + WS_XH), (f16*)(ws + WS_XH), ((l == NLAYER - 1) ? (float*)karg<18>() + O_YP : (float*)nullptr), 0.5f, (const float*)karg<16>() + (size_t)l * 3 * D + 2 * D, (const float*)karg<17>() + (size_t)l * 3 * D + 2 * D, ws + WS_X, (unsigned*)(ws + WS_CTL) + CW_PANEL, (unsigned)(l * 3 + 2) + 1u}; pg8::gemm_phase(LDSP(), g, S, E, wave_s);
          pg8::tail_gemm_lds(LDSP(), g.A, g.Bt, g.N, g.K, opaque_s(G), opaque_s(blk), E, wave_s); }
        if (l + 1 < NLAYER) GRID_BAR();
    }
}

extern "C" void kernel_launch(void* const* d_in, const int* in_sizes, int n_in, void* d_out, int out_size, void* d_ws, size_t ws_size, hipStream_t stream) {
    static int inited = 0;
    if (!inited) {
        if (ws_size < WS_END) fprintf(stderr, "kernel_launch: workspace too small: %zu < %zu\n", ws_size, (size_t)WS_END);
        (void)hipFuncSetAttribute((const void*)mega_fwd, hipFuncAttributeMaxDynamicSharedMemorySize, LDS_BYTES);
        inited = 1;
    }
    Args a{};
    a.x_prompt = (const float*)d_in[0]; a.x_sample = (const float*)d_in[1]; a.state_hgrn = (const float*)d_in[2]; a.state_conv = (const float*)d_in[3];
    a.meta = (const float*)d_in[4]; a.w_in = (const float*)d_in[5]; a.lb_logits = (const float*)d_in[6]; a.norm_w = (const float*)d_in[7]; a.conv_w = (const float*)d_in[8];
    a.w_a = (const float*)d_in[9]; a.w_b = (const float*)d_in[10]; a.w_o = (const float*)d_in[11]; a.gu1 = (const float*)d_in[12]; a.dn1 = (const float*)d_in[13];
    a.gu2 = (const float*)d_in[14]; a.dn2 = (const float*)d_in[15]; a.ln_g = (const float*)d_in[16]; a.ln_b = (const float*)d_in[17];
    a.out = (float*)d_out; a.ws = (unsigned char*)d_ws;
    if (hipMemsetAsync((char*)d_ws + WS_CTL, 0, 65536, stream) != hipSuccess) fprintf(stderr, "memset failed\n");
    void* args[] = {&a};
    hipError_t e = hipLaunchCooperativeKernel((const void*)mega_fwd, dim3(256), dim3(512), args, LDS_BYTES, stream);
    if (e != hipSuccess) fprintf(stderr, "cooperative launch failed: %s\n", hipGetErrorString(e));
}
```

```cpp
#include <hip/hip_runtime.h>
#include <hip/hip_cooperative_groups.h>
#include <cstdio>
#include <cstdint>
namespace cg = cooperative_groups;

#define LAS __attribute__((address_space(3)))
typedef _Float16 f16;
typedef _Float16 f16x8 __attribute__((ext_vector_type(8)));
typedef _Float16 f16x4 __attribute__((ext_vector_type(4)));
typedef _Float16 f16x2 __attribute__((ext_vector_type(2)));
typedef short s16x8 __attribute__((ext_vector_type(8)));
typedef float f32x4 __attribute__((ext_vector_type(4)));
typedef float f32x2 __attribute__((ext_vector_type(2)));
typedef unsigned u32x4 __attribute__((ext_vector_type(4)));
typedef unsigned u32x2 __attribute__((ext_vector_type(2)));

constexpr int D = 1024, DFF = 2816, NIN = 9216, NLAYER = 4;
constexpr int BP = 8, TP = 2064, SEQP = 2048, NMETA = 16, MP = BP * TP;
constexpr int BS = 128, TS = 4, MS = BS * TS;
constexpr int MROWS = MP + MS;
constexpr int MAIN = BP * SEQP;
constexpr int META0 = MAIN, SAMP0 = MAIN + BP * NMETA;
constexpr int NTAIL = MROWS - MAIN;
constexpr int MPAD = 17152;
constexpr int NH = 8, DK = 128, DV = 128;
constexpr float ALPHA = 1.6817928305074290f;
constexpr float LN_EPS = 1e-5f, RMS_EPS = 1e-6f;

constexpr size_t O_YP = 0, O_YS = (size_t)BP * SEQP * D, O_HP = O_YS + (size_t)MS * D, O_CP = O_HP + (size_t)NLAYER * BP * NH * DK * DV,
                 O_HS = O_CP + (size_t)NLAYER * BP * 2 * D, O_CS = O_HS + (size_t)NLAYER * BS * NH * DK * DV;

constexpr size_t W_GU1 = 0, W_DN1 = W_GU1 + (size_t)2 * DFF * D, W_IN = W_DN1 + (size_t)D * DFF, W_A = W_IN + (size_t)NIN * D, W_B = W_A + (size_t)D * D,
                 W_O = W_B + (size_t)D * D, W_GU2 = W_O + (size_t)D * D, W_DN2 = W_GU2 + (size_t)2 * DFF * D, W_LAYER = W_DN2 + (size_t)D * DFF;

constexpr size_t AL(size_t x) { return (x + 4095) & ~(size_t)4095; }
constexpr size_t WS_CTL = 0;
constexpr size_t WS_LB = 1u << 20;
constexpr size_t WS_W = WS_LB + 65536;
constexpr size_t WS_X = AL(WS_W + W_LAYER * NLAYER * 2);
constexpr size_t SZ16 = (size_t)MPAD * D * 2, SZ32 = (size_t)MPAD * D * 4;
constexpr size_t WS_XH = AL(WS_X + SZ32);
constexpr size_t WS_Q = AL(WS_XH + SZ16);
constexpr size_t WS_V = WS_Q + SZ16;
constexpr size_t WS_SOG = WS_V + SZ16;
constexpr size_t WS_H = WS_Q;
static_assert((size_t)MPAD * DFF * 2 <= 3 * SZ16, "H overlay");
constexpr size_t WS_LF = AL(WS_SOG + SZ16);
constexpr size_t WS_BG = AL(WS_LF + SZ32);
constexpr size_t WS_U = WS_BG + SZ16;
constexpr size_t WS_SGA = WS_U + SZ16;
constexpr size_t WS_SGB = WS_SGA + SZ16;
constexpr size_t WS_O = WS_SGB + SZ16;
constexpr size_t WS_CB = WS_O + SZ16;
constexpr size_t WS_MM = WS_CB + SZ16;
constexpr size_t WS_SS = AL(WS_MM + SZ16);
constexpr size_t WS_END = WS_SS + (size_t)MPAD * 64 * 4;

constexpr int LDS_BYTES = 147456;
constexpr int XB_LDS_OFF = 147456 - 64;

__device__ __forceinline__ unsigned f2bf(float f) { unsigned u = __builtin_bit_cast(unsigned, f); return (u + 0x7fffu + ((u >> 16) & 1u)) >> 16; }
__device__ __forceinline__ unsigned pkh(float lo, float hi) { f16x2 v = {(f16)lo, (f16)hi}; return __builtin_bit_cast(unsigned, v); }
__device__ __forceinline__ unsigned pkb(float lo, float hi) { unsigned r; asm("v_cvt_pk_bf16_f32 %0, %1, %2" : "=v"(r) : "v"(lo), "v"(hi)); return r; }
__device__ __forceinline__ float sigmoidf_(float x) { return __builtin_amdgcn_rcpf(1.0f + __expf(-x)); }
#define LDS_WAIT() asm volatile("s_waitcnt lgkmcnt(0)" ::: "memory")
__device__ __forceinline__ int opaque_tid(int wave_s) { int t; asm volatile("v_mbcnt_lo_u32_b32 %0, -1, 0\n\tv_mbcnt_hi_u32_b32 %0, -1, %0" : "=v"(t)); return wave_s * 64 + t; }
template <int IDX> __device__ __forceinline__ unsigned char* karg() { __attribute__((address_space(1))) unsigned char* v;
#if defined(__HIP_DEVICE_COMPILE__)
    auto p = __builtin_amdgcn_kernarg_segment_ptr();
    asm volatile("s_load_dwordx2 %0, %1, %2\n\ts_waitcnt lgkmcnt(0)" : "=s"(v) : "s"(p), "n"(IDX * 8));
#else
    v = nullptr;
#endif
    return (unsigned char*)v; }
__device__ __forceinline__ int opaque_s(int x) { asm volatile("" : "+s"(x)); return x; }

__device__ __forceinline__ unsigned pn_ld(unsigned* p)              { return __hip_atomic_load(p, __ATOMIC_RELAXED, __HIP_MEMORY_SCOPE_AGENT); }
__device__ __forceinline__ unsigned pn_add(unsigned* p, unsigned v) { return __hip_atomic_fetch_add(p, v, __ATOMIC_RELAXED, __HIP_MEMORY_SCOPE_AGENT); }
__device__ __forceinline__ void slot_st(f32x2* p, f32x2 v) { __hip_atomic_store((unsigned long long*)p, __builtin_bit_cast(unsigned long long, v), __ATOMIC_RELAXED, __HIP_MEMORY_SCOPE_AGENT); }
__device__ __forceinline__ f32x2 slot_ld(const f32x2* p) { return __builtin_bit_cast(f32x2, __hip_atomic_load((unsigned long long*)p, __ATOMIC_RELAXED, __HIP_MEMORY_SCOPE_AGENT)); }
__device__ __forceinline__ void panel_arrive(unsigned* cnt, int tid) {
    asm volatile("s_waitcnt vmcnt(0)" ::: "memory");
    __syncthreads();
    if (tid == 0) { __builtin_amdgcn_fence(__ATOMIC_RELEASE, "agent"); asm volatile("s_waitcnt vmcnt(0)" ::: "memory"); (void)pn_add(cnt, 1u); }
}
__device__ __forceinline__ void panel_wait(unsigned* cnt, unsigned target, int tid) {
    if (tid == 0) { unsigned sp = 0u; while (pn_ld(cnt) < target) { __builtin_amdgcn_s_sleep(1); if (++sp > (1u << 22)) break; }
        __builtin_amdgcn_fence(__ATOMIC_ACQUIRE, "agent"); asm volatile("s_waitcnt vmcnt(0)" ::: "memory"); }
    __syncthreads();
}
constexpr int CW_PANEL = 8192;
constexpr size_t XS_MAIN = 0, XS_TAIL = 1u << 20;

namespace pg8 {
constexpr int BM = 256, BK = 64, HALF = 128, HTB = HALF * BK * 2, STAGE_BYTES = 8 * HTB, NXCD = 8, WGM = 4;
__host__ __device__ __forceinline__ int lds_byte(int r, int c) { const int st = (r >> 4) * 2 + (c >> 5), rr = r & 15, cc = c & 31, ob = rr * 64 + cc * 2; return st * 1024 + (ob ^ (((ob >> 9) & 1) << 5)); }
__host__ __device__ __forceinline__ void stage_rc(int b, int& R, int& C) { const int st = b / 1024, sb = b % 1024, swz = sb ^ (((sb >> 9) & 1) << 5); R = (st >> 1) * 16 + swz / 64; C = (st & 1) * 32 + (swz % 64) / 2; }
__host__ __device__ __forceinline__ int perm32(int rho) { const int n = rho >> 4, i = rho & 15; return 8 * (i >> 2) + 4 * n + (i & 3); }

struct Unit { int pm, pn; };
struct Gemm { const f16* A; const f16* Bt; int M, N, K; };

struct StaticOrder {
    int nM, nN, nwg, G, c;
    __device__ void init(int M, int N, int G_, int c_) { nM = M / BM; nN = N / BM; nwg = nM * nN; G = G_; c = c_; }
    __device__ bool next(int i, Unit& u) const {
        const long L = (long)i * G + c; if (L >= nwg) return false;
        int wgid = (int)L; { const int q = nwg / NXCD, r = nwg % NXCD, xcd = wgid % NXCD, off = wgid / NXCD; wgid = (xcd < r ? xcd * (q + 1) : r * (q + 1) + (xcd - r) * q) + off; }
        const int nig = WGM * nN, gid = wgid / nig, fm = gid * WGM, gsz = (nM - fm) < WGM ? (nM - fm) : WGM;
        u.pm = fm + ((wgid % nig) % gsz); u.pn = (wgid % nig) / gsz; return true;
    }
};

template <class Epi>
__device__ __forceinline__ void gemm_phase(LAS unsigned char* lds, const Gemm g, const StaticOrder& S, const Epi& E, int wave_s) {
    const int tid = opaque_tid(wave_s), wid = __builtin_amdgcn_readfirstlane(tid >> 6), lane = tid & 63, wr = wid >> 2, wc = wid & 3, fr = lane & 15, fq = lane >> 4;
    const int K = g.K, nt = K / BK;
    unsigned voffA[2], voffB[2];
#pragma unroll
    for (int i = 0; i < 2; ++i) { int R, C; stage_rc(tid * 16 + i * 8192, R, C); const int Rb = Epi::PERM ? ((R & ~31) + perm32(R & 31)) : R;
        voffA[i] = (unsigned)(R * K + C) * 2u; voffB[i] = (unsigned)(Rb * K + C) * 2u; }
    const size_t kstep = (size_t)(BK * 2);
    const size_t hstep = (size_t)HALF * K * 2;
    const size_t tstep = 2 * hstep;
    const unsigned ldsw = (unsigned)wid * 1024u;
    const int aoff = lds_byte(wr * 64 + fr, fq * 8), boff = lds_byte(wc * 32 + fr, fq * 8);
#define PG8_SA(b, h) (((b) * 2 + (h)) * HTB)
#define PG8_SB(b, h) ((4 + (b) * 2 + (h)) * HTB)
#define PG8_STAGE(bufoff, gbase, voff) do { _Pragma("unroll") for (int _i = 0; _i < 2; ++_i) \
        __builtin_amdgcn_global_load_lds((const unsigned*)((const char*)(gbase) + (voff)[_i]), (LAS unsigned*)(lds + (bufoff) + ldsw + _i * 8192), 16, 0, 0); } while (0)
#define PG8_LDA(dst, b, h) do { _Pragma("unroll") for (int m = 0; m < 4; ++m) _Pragma("unroll") for (int k = 0; k < 2; ++k) dst[m][k] = *(const LAS f16x8*)(lds + PG8_SA(b, h) + aoff + m * 2048 + k * 1024); } while (0)
#define PG8_LDB(dst, b, h) do { _Pragma("unroll") for (int n = 0; n < 2; ++n) _Pragma("unroll") for (int k = 0; k < 2; ++k) dst[n][k] = *(const LAS f16x8*)(lds + PG8_SB(b, h) + boff + n * 2048 + k * 1024); } while (0)
#define PG8_MMA(ai, bj, At, Bt) do { __builtin_amdgcn_s_setprio(1); _Pragma("unroll") for (int m = 0; m < 4; ++m) _Pragma("unroll") for (int n = 0; n < 2; ++n) _Pragma("unroll") for (int k = 0; k < 2; ++k) \
        acc[ai][bj][m][n] = __builtin_amdgcn_mfma_f32_16x16x32_f16(Bt[n][k], At[m][k], acc[ai][bj][m][n], 0, 0, 0); __builtin_amdgcn_s_setprio(0); } while (0)
#define PG8_WAIT_V(n) asm volatile("s_waitcnt vmcnt(" #n ")" ::: "memory")
#define PG8_WAIT_L(n) asm volatile("s_waitcnt lgkmcnt(" #n ")" ::: "memory")
#define PG8_BAR __builtin_amdgcn_s_barrier()
#define PG8_SCHED __builtin_amdgcn_sched_barrier(0)
    Unit cur, nxt; int ui = 0;
    if (!S.next(0, cur)) return;
    f32x4 acc[2][2][4][2];
#pragma unroll
    for (int a = 0; a < 2; ++a)
#pragma unroll
        for (int b = 0; b < 2; ++b)
#pragma unroll
            for (int m = 0; m < 4; ++m)
#pragma unroll
                for (int n = 0; n < 2; ++n) acc[a][b][m][n] = (f32x4){0.f, 0.f, 0.f, 0.f};
    f16x8 At[4][2], B0[2][2], B1[2][2];
    const char* cA = (const char*)g.A + (size_t)cur.pm * tstep; const char* cB = (const char*)g.Bt + (size_t)cur.pn * tstep;
    PG8_STAGE(PG8_SB(0, 0), cB, voffB); PG8_STAGE(PG8_SB(0, 1), cB + hstep, voffB); PG8_STAGE(PG8_SA(0, 0), cA, voffA); PG8_STAGE(PG8_SA(0, 1), cA + hstep, voffA);
    if (wr == 1) PG8_BAR;
    PG8_WAIT_V(2); PG8_BAR;
    PG8_STAGE(PG8_SB(1, 0), cB + kstep, voffB); PG8_STAGE(PG8_SA(1, 0), cA + kstep, voffA); PG8_STAGE(PG8_SB(1, 1), cB + hstep + kstep, voffB);
    PG8_WAIT_V(6); PG8_BAR;
    for (;;) {
        const bool has_next = S.next(ui + 1, nxt);
        const char* nA = has_next ? (const char*)g.A + (size_t)nxt.pm * tstep : cA; const char* nB = has_next ? (const char*)g.Bt + (size_t)nxt.pn * tstep : cB;
#define PG8_KBODY \
            const bool last = (t == nt - 2); \
            const char* a1 = cA + (size_t)(t + 1) * kstep; \
            const char* a2 = last ? nA : cA + (size_t)(t + 2) * kstep; const char* b2 = last ? nB : cB + (size_t)(t + 2) * kstep; \
            const char* a3 = a2 + kstep; const char* b3 = b2 + kstep; \
            PG8_LDB(B0, 0, 0); PG8_LDB(B1, 0, 1); PG8_SCHED; PG8_LDA(At, 0, 0); PG8_STAGE(PG8_SA(1, 1), a1 + hstep, voffA); \
            PG8_WAIT_V(8); PG8_WAIT_L(0); PG8_BAR; PG8_MMA(0, 0, At, B0); PG8_MMA(0, 1, At, B1); PG8_BAR; PG8_SCHED; \
            PG8_LDA(At, 0, 1); PG8_STAGE(PG8_SB(0, 0), b2, voffB); PG8_STAGE(PG8_SB(0, 1), b2 + hstep, voffB); PG8_STAGE(PG8_SA(0, 0), a2, voffA); \
            PG8_WAIT_V(8); PG8_WAIT_L(0); PG8_BAR; PG8_MMA(1, 0, At, B0); PG8_MMA(1, 1, At, B1); PG8_BAR; PG8_SCHED; \
            PG8_LDB(B0, 1, 0); PG8_LDB(B1, 1, 1); PG8_SCHED; PG8_LDA(At, 1, 0); PG8_STAGE(PG8_SA(0, 1), a2 + hstep, voffA); \
            PG8_WAIT_V(8); PG8_WAIT_L(0); PG8_BAR; PG8_MMA(0, 0, At, B0); PG8_MMA(0, 1, At, B1); PG8_BAR; PG8_SCHED; \
            PG8_LDA(At, 1, 1); PG8_STAGE(PG8_SB(1, 0), b3, voffB); PG8_STAGE(PG8_SB(1, 1), b3 + hstep, voffB); PG8_STAGE(PG8_SA(1, 0), a3, voffA); \
            PG8_WAIT_V(8); PG8_WAIT_L(0); PG8_BAR; PG8_MMA(1, 0, At, B0); PG8_MMA(1, 1, At, B1); PG8_BAR; PG8_SCHED;
        if constexpr (Epi::HOOK) {
            for (int t = 0; t < (nt >> 1); t += 2) { PG8_KBODY }
            E.hook(acc, cur, wr, wc, fr, fq);
            for (int t = (nt >> 1); t < nt; t += 2) { PG8_KBODY }
        } else {
            for (int t = 0; t < nt; t += 2) { PG8_KBODY }
        }
#undef PG8_KBODY
        if constexpr (!Epi::AFTER_DRAIN) E(acc, cur, wr, wc, fr, fq);
        if (!has_next) break;
#pragma unroll
        for (int a = 0; a < 2; ++a)
#pragma unroll
            for (int b = 0; b < 2; ++b)
#pragma unroll
                for (int m = 0; m < 4; ++m)
#pragma unroll
                    for (int n = 0; n < 2; ++n) acc[a][b][m][n] = (f32x4){0.f, 0.f, 0.f, 0.f};
        cur = nxt; cA = nA; cB = nB; ++ui;
    }
    PG8_WAIT_V(0);
    if (wr == 0) PG8_BAR;
    PG8_BAR;
    if constexpr (Epi::AFTER_DRAIN) E.fused(acc, cur, wr, wc, fr, fq, lds, tid);
#undef PG8_SA
#undef PG8_SB
#undef PG8_STAGE
#undef PG8_LDA
#undef PG8_LDB
#undef PG8_MMA
#undef PG8_WAIT_V
#undef PG8_WAIT_L
#undef PG8_BAR
#undef PG8_SCHED
}

struct EpiGU {
    static constexpr bool PERM = true, HOOK = false, AFTER_DRAIN = false;
    f16* H;
    __device__ __forceinline__ static bool paired(int) { return true; }
    __device__ __forceinline__ void tail(int row, int pn, int cc0, int cc1, const f32x4& v0, const f32x4& v1) const {
        float h[4];
#pragma unroll
        for (int j = 0; j < 4; ++j) h[j] = v0[j] * sigmoidf_(v0[j]) * v1[j];
        u32x2 w; w.x = pkh(h[0], h[1]); w.y = pkh(h[2], h[3]); *(u32x2*)(H + (size_t)row * DFF + (cc0 - 128 * pn)) = w;
    }
    __device__ __forceinline__ void operator()(const f32x4 (&acc)[2][2][4][2], const Unit& u, int wr, int wc, int fr, int fq) const {
        const int row0 = u.pm * BM + wr * 64 + fr, col0 = u.pn * 128 + wc * 32 + 8 * fq;
#pragma unroll
        for (int ai = 0; ai < 2; ++ai)
#pragma unroll
            for (int m = 0; m < 4; ++m) {
                float h[8];
#pragma unroll
                for (int n = 0; n < 2; ++n)
#pragma unroll
                    for (int j = 0; j < 4; ++j) { const float gv = acc[ai][0][m][n][j], uv = acc[ai][1][m][n][j]; h[n * 4 + j] = gv * sigmoidf_(gv) * uv; }
                u32x4 w; w.x = pkh(h[0], h[1]); w.y = pkh(h[2], h[3]); w.z = pkh(h[4], h[5]); w.w = pkh(h[6], h[7]);
                *(u32x4*)(H + (size_t)(row0 + ai * HALF + m * 16) * DFF + col0) = w;
            }
    }
};
struct EpiResLN {
    static constexpr bool PERM = false, HOOK = false, AFTER_DRAIN = true;
    const f16* XHr; f16* XHw; float* outp; float scale; const float* gam; const float* bet; unsigned char* xs; unsigned* cnt; unsigned inst;
    __device__ __forceinline__ static bool paired(int) { return false; }
    __device__ __forceinline__ void operator()(const f32x4 (&)[2][2][4][2], const Unit&, int, int, int, int) const {}
    __device__ __forceinline__ void fused(f32x4 (&acc)[2][2][4][2], const Unit& u, int wr, int wc, int fr, int fq, LAS unsigned char* lds, int tid) const {
        const int rt0 = wr * 64 + fr, col0 = u.pn * BM + wc * 32 + 4 * fq;
        LAS f32x2* P = (LAS f32x2*)lds; LAS f32x2* ST = (LAS f32x2*)(lds + 8192);
        {
            const f16* px = XHr + (size_t)(u.pm * BM + rt0) * D + col0;
#pragma unroll
            for (int ai = 0; ai < 2; ++ai) {
#pragma unroll
                for (int m = 0; m < 4; ++m) {
                    asm volatile("" : "+v"(px));
                    float sm = 0.f, sq = 0.f;
#pragma unroll
                    for (int bj = 0; bj < 2; ++bj)
#pragma unroll
                        for (int n = 0; n < 2; ++n) { const f16x4 h = *(const f16x4*)(px + bj * HALF + n * 16);
#pragma unroll
                            for (int j = 0; j < 4; ++j) { const float t = (float)h[j] * ALPHA + acc[ai][bj][m][n][j] * scale; acc[ai][bj][m][n][j] = t; sm += t; sq += t * t; } }
                    sm += __shfl_xor(sm, 16); sm += __shfl_xor(sm, 32); sq += __shfl_xor(sq, 16); sq += __shfl_xor(sq, 32);
                    if (fq == 0) P[(ai * HALF + m * 16 + rt0) * 4 + wc] = (f32x2){sm, sq};
                    px += 16 * D;
                    __builtin_amdgcn_sched_barrier(0);
                }
                px += 64 * D;
            }
        }
        __syncthreads();
        f32x2* slot = (f32x2*)(xs + XS_MAIN) + (size_t)(u.pm * 256) * 4;
        if (tid < 256) { const f32x2 a = P[tid * 4 + 0], b = P[tid * 4 + 1], c = P[tid * 4 + 2], d = P[tid * 4 + 3];
            slot_st(slot + u.pn * 256 + tid, (f32x2){(a.x + b.x) + (c.x + d.x), (a.y + b.y) + (c.y + d.y)}); }
        panel_arrive(cnt + 64 * u.pm, tid);
        panel_wait(cnt + 64 * u.pm, 4u * inst, tid);
        if (tid < 256) { const f32x2 a = slot_ld(slot + tid), b = slot_ld(slot + 256 + tid), c = slot_ld(slot + 512 + tid), d = slot_ld(slot + 768 + tid);
            const float mean = ((a.x + b.x) + (c.x + d.x)) * (1.f / D), ex2 = ((a.y + b.y) + (c.y + d.y)) * (1.f / D);
            ST[tid] = (f32x2){mean, 1.0f / sqrtf(fmaxf(ex2 - mean * mean, 0.f) + LN_EPS)}; }
        __syncthreads();
        {
            f32x4 gv[2][2], bv[2][2];
#pragma unroll
            for (int bj = 0; bj < 2; ++bj)
#pragma unroll
                for (int n = 0; n < 2; ++n) { gv[bj][n] = *(const f32x4*)(gam + col0 + bj * HALF + n * 16); bv[bj][n] = *(const f32x4*)(bet + col0 + bj * HALF + n * 16); }
            size_t ro = (size_t)(u.pm * BM + rt0) * D + col0;
#pragma unroll
            for (int ai = 0; ai < 2; ++ai) {
#pragma unroll
                for (int m = 0; m < 4; ++m) {
                    asm volatile("" : "+v"(ro));
                    const f32x2 st = ST[ai * HALF + m * 16 + rt0];
#pragma unroll
                    for (int bj = 0; bj < 2; ++bj)
#pragma unroll
                        for (int n = 0; n < 2; ++n) { const f32x4 y = (acc[ai][bj][m][n] - st.x) * st.y * gv[bj][n] + bv[bj][n];
                            if (outp) *(f32x4*)(outp + ro + bj * HALF + n * 16) = y;
                            else { u32x2 w; w.x = pkh(y.x, y.y); w.y = pkh(y.z, y.w); *(u32x2*)(XHw + ro + bj * HALF + n * 16) = w; } }
                    ro += 16 * D;
                }
                ro += 64 * D;
            }
        }
        __syncthreads();
    }
    __device__ __forceinline__ void tail(int, int, int, int, const f32x4&, const f32x4&) const {}
    __device__ __forceinline__ void tail_fused(int rg, int cg, int wave_s, int fr, int fq, f32x4 v0, f32x4 v1, int tid) const {
        const int rin = 16 * wave_s + fr, row = MAIN + 128 * rg + rin, c0 = 32 * cg + 4 * fq, c1 = c0 + 16;
        const size_t o0 = (size_t)row * D + c0, o1 = (size_t)row * D + c1;
        const f16x4 h0 = *(const f16x4*)(XHr + o0), h1 = *(const f16x4*)(XHr + o1);
        float sm = 0.f, sq = 0.f;
#pragma unroll
        for (int j = 0; j < 4; ++j) { v0[j] = (float)h0[j] * ALPHA + v0[j] * scale; v1[j] = (float)h1[j] * ALPHA + v1[j] * scale; sm += v0[j] + v1[j]; sq += v0[j] * v0[j] + v1[j] * v1[j]; }
        sm += __shfl_xor(sm, 16); sm += __shfl_xor(sm, 32); sq += __shfl_xor(sq, 16); sq += __shfl_xor(sq, 32);
        f32x2* slot = (f32x2*)(xs + XS_TAIL) + (size_t)(rg * 128) * 32;
        if (fq == 0) slot_st(slot + cg * 128 + rin, (f32x2){sm, sq});
        panel_arrive(cnt + 64 * (64 + rg), tid);
        panel_wait(cnt + 64 * (64 + rg), 32u * inst, tid);
        float ts = 0.f, tq = 0.f;
#pragma unroll
        for (int k = 0; k < 8; ++k) { const f32x2 p = slot_ld(slot + (fq * 8 + k) * 128 + rin); ts += p.x; tq += p.y; }
        ts += __shfl_xor(ts, 16); ts += __shfl_xor(ts, 32); tq += __shfl_xor(tq, 16); tq += __shfl_xor(tq, 32);
        const float mean = ts * (1.f / D), rstd = 1.0f / sqrtf(fmaxf(tq * (1.f / D) - mean * mean, 0.f) + LN_EPS);
        const f32x4 g0 = *(const f32x4*)(gam + c0), g1 = *(const f32x4*)(gam + c1), b0 = *(const f32x4*)(bet + c0), b1 = *(const f32x4*)(bet + c1);
        const f32x4 y0 = (v0 - mean) * rstd * g0 + b0, y1 = (v1 - mean) * rstd * g1 + b1;
        if (outp) { if (row >= SAMP0) { float* d = outp + (O_YS - O_YP) + (size_t)(row - SAMP0) * D; *(f32x4*)(d + c0) = y0; *(f32x4*)(d + c1) = y1; } }
        else { u32x2 w0, w1; w0.x = pkh(y0.x, y0.y); w0.y = pkh(y0.z, y0.w); w1.x = pkh(y1.x, y1.y); w1.y = pkh(y1.z, y1.w); *(u32x2*)(XHw + o0) = w0; *(u32x2*)(XHw + o1) = w1; }
    }
};
struct EpiMerge {
    static constexpr bool PERM = false, HOOK = true, AFTER_DRAIN = false;
    const f16* SGA; const f16* SGB; f16* MM;
    __device__ __forceinline__ static bool paired(int) { return false; }
    __device__ __forceinline__ static float ratio(f16 a, f16 b) { return (float)a * __builtin_amdgcn_rcpf(fmaxf((float)b, 1e-4f)); }
    __device__ __forceinline__ void tail_hook(int row, int cc0, int cc1, f32x4& v0, f32x4& v1) const {
        const size_t o0 = (size_t)row * D + cc0, o1 = (size_t)row * D + cc1;
        const f16x4 a0 = *(const f16x4*)(SGA + o0), a1 = *(const f16x4*)(SGA + o1), b0 = *(const f16x4*)(SGB + o0), b1 = *(const f16x4*)(SGB + o1);
#pragma unroll
        for (int j = 0; j < 4; ++j) { v0[j] *= ratio(a0[j], b0[j]); v1[j] *= ratio(a1[j], b1[j]); }
    }
    __device__ __forceinline__ void tail(int row, int pn, int cc0, int cc1, const f32x4& v0, const f32x4& v1) const {
        const size_t o0 = (size_t)row * D + cc0, o1 = (size_t)row * D + cc1; const f16x4 g0 = *(const f16x4*)(SGB + o0), g1 = *(const f16x4*)(SGB + o1);
        float r0[4], r1[4];
#pragma unroll
        for (int j = 0; j < 4; ++j) { r0[j] = v0[j] * fmaxf((float)g0[j], 1e-4f); r1[j] = v1[j] * fmaxf((float)g1[j], 1e-4f); }
        u32x2 w0, w1; w0.x = pkh(r0[0], r0[1]); w0.y = pkh(r0[2], r0[3]); w1.x = pkh(r1[0], r1[1]); w1.y = pkh(r1[2], r1[3]);
        *(u32x2*)(MM + o0) = w0; *(u32x2*)(MM + o1) = w1;
    }
    __device__ __forceinline__ void hook(f32x4 (&acc)[2][2][4][2], const Unit& u, int wr, int wc, int fr, int fq) const {
        const int row0 = u.pm * BM + wr * 64 + fr, col0 = u.pn * BM + wc * 32 + 4 * fq;
        const f16* pa = SGA + (size_t)row0 * D + col0; const f16* pb = SGB + (size_t)row0 * D + col0;
#pragma unroll
        for (int ai = 0; ai < 2; ++ai) {
#pragma unroll
            for (int m = 0; m < 4; ++m) {
                asm volatile("" : "+v"(pa), "+v"(pb));
#pragma unroll
                for (int bj = 0; bj < 2; ++bj)
#pragma unroll
                    for (int n = 0; n < 2; ++n) { const f16x4 ga = *(const f16x4*)(pa + bj * HALF + n * 16), gb = *(const f16x4*)(pb + bj * HALF + n * 16);
#pragma unroll
                        for (int j = 0; j < 4; ++j) acc[ai][bj][m][n][j] *= ratio(ga[j], gb[j]); }
                pa += 16 * D; pb += 16 * D;
                __builtin_amdgcn_sched_barrier(0);
            }
            pa += 64 * D; pb += 64 * D;
        }
    }
    __device__ __forceinline__ void operator()(const f32x4 (&acc)[2][2][4][2], const Unit& u, int wr, int wc, int fr, int fq) const {
        const int row0 = u.pm * BM + wr * 64 + fr, col0 = u.pn * BM + wc * 32 + 4 * fq;
#pragma unroll
        for (int ai = 0; ai < 2; ++ai)
#pragma unroll
            for (int m = 0; m < 4; ++m) { const size_t ro = (size_t)(row0 + ai * HALF + m * 16) * D + col0;
#pragma unroll
                for (int bj = 0; bj < 2; ++bj)
#pragma unroll
                    for (int n = 0; n < 2; ++n) { const size_t o = ro + bj * HALF + n * 16; const f16x4 gq = *(const f16x4*)(SGB + o);
                        u32x2 w; w.x = pkh(acc[ai][bj][m][n].x * fmaxf((float)gq.x, 1e-4f), acc[ai][bj][m][n].y * fmaxf((float)gq.y, 1e-4f));
                        w.y = pkh(acc[ai][bj][m][n].z * fmaxf((float)gq.z, 1e-4f), acc[ai][bj][m][n].w * fmaxf((float)gq.w, 1e-4f));
                        *(u32x2*)(MM + o) = w; } }
    }
};
struct EpiIn {
    static constexpr bool PERM = true, HOOK = false, AFTER_DRAIN = false;
    f16 *Q, *V, *SOG, *BG, *U, *SGA, *SGB; float* LF; const float* LB;
    __device__ __forceinline__ static bool paired(int pn) { return pn >= 20 && pn < 28; }
    template <int FN> __device__ __forceinline__ static void store_fn(const f32x4 (&acc)[2][2][4][2], f16* dst, int row0, int col0) {
#pragma unroll
        for (int ai = 0; ai < 2; ++ai)
#pragma unroll
            for (int m = 0; m < 4; ++m)
#pragma unroll
                for (int bj = 0; bj < 2; ++bj) {
                    float h[8];
#pragma unroll
                    for (int n = 0; n < 2; ++n)
#pragma unroll
                        for (int j = 0; j < 4; ++j) { const float x = acc[ai][bj][m][n][j]; float r = x;
                            if (FN != 0) { const float sg = sigmoidf_(x); r = (FN == 1) ? x * sg : sg; }
                            h[n * 4 + j] = r; }
                    u32x4 w; w.x = pkh(h[0], h[1]); w.y = pkh(h[2], h[3]); w.z = pkh(h[4], h[5]); w.w = pkh(h[6], h[7]);
                    *(u32x4*)(dst + (size_t)(row0 + ai * HALF + m * 16) * D + col0 + bj * HALF) = w;
                }
    }
    __device__ __forceinline__ void tail1(int row, int pn, int cc, const f32x4& v) const {
        const int cl = cc - 256 * pn;
        if (pn >= 4 && pn < 8) { const int col = (pn - 4) * 256 + cl; const f32x4 lb = *(const f32x4*)(LB + col); f32x4 r;
#pragma unroll
            for (int j = 0; j < 4; ++j) r[j] = lb[j] + (1.0f - lb[j]) * sigmoidf_(v[j]);
            *(f32x4*)(LF + (size_t)row * D + col) = r; return; }
        f16* dst; int fn, cbase;
        if (pn < 4) { dst = Q; fn = 1; cbase = pn * 256; }
        else if (pn < 12) { dst = V; fn = 0; cbase = (pn - 8) * 256; }
        else if (pn < 16) { dst = SOG; fn = 1; cbase = (pn - 12) * 256; }
        else if (pn < 20) { dst = BG; fn = 0; cbase = (pn - 16) * 256; }
        else if (pn < 32) { dst = SGA; fn = 2; cbase = (pn - 28) * 256; }
        else { dst = SGB; fn = 2; cbase = (pn - 32) * 256; }
        float h[4];
#pragma unroll
        for (int j = 0; j < 4; ++j) { const float x = v[j]; float r = x; if (fn != 0) { const float sg = sigmoidf_(x); r = (fn == 1) ? x * sg : sg; } h[j] = r; }
        u32x2 w; w.x = pkh(h[0], h[1]); w.y = pkh(h[2], h[3]); *(u32x2*)(dst + (size_t)row * D + cbase + cl) = w;
    }
    __device__ __forceinline__ void tail(int row, int pn, int cc0, int cc1, const f32x4& v0, const f32x4& v1) const {
        if (pn >= 20 && pn < 28) { u32x2 w; w.x = pkh(v0[0] * v1[0], v0[1] * v1[1]); w.y = pkh(v0[2] * v1[2], v0[3] * v1[3]);
            *(u32x2*)(U + (size_t)row * D + (pn - 20) * 128 + (cc0 - 256 * pn)) = w; return; }
        tail1(row, pn, cc0, v0); tail1(row, pn, cc1, v1);
    }
    __device__ __forceinline__ void operator()(const f32x4 (&acc)[2][2][4][2], const Unit& u, int wr, int wc, int fr, int fq) const {
        const int row0 = u.pm * BM + wr * 64 + fr, pn = u.pn;
        if (pn >= 20 && pn < 28) {
            const int col0 = (pn - 20) * 128 + wc * 32 + 8 * fq;
#pragma unroll
            for (int ai = 0; ai < 2; ++ai)
#pragma unroll
                for (int m = 0; m < 4; ++m) {
                    float h[8];
#pragma unroll
                    for (int n = 0; n < 2; ++n)
#pragma unroll
                        for (int j = 0; j < 4; ++j) h[n * 4 + j] = acc[ai][0][m][n][j] * acc[ai][1][m][n][j];
                    u32x4 w; w.x = pkh(h[0], h[1]); w.y = pkh(h[2], h[3]); w.z = pkh(h[4], h[5]); w.w = pkh(h[6], h[7]);
                    *(u32x4*)(U + (size_t)(row0 + ai * HALF + m * 16) * D + col0) = w;
                }
        } else if (pn >= 4 && pn < 8) {
            const int col0 = (pn - 4) * 256 + wc * 32 + 8 * fq;
#pragma unroll
            for (int bj = 0; bj < 2; ++bj) {
                const f32x4 lb0 = *(const f32x4*)(LB + col0 + bj * HALF), lb1 = *(const f32x4*)(LB + col0 + bj * HALF + 4);
#pragma unroll
                for (int ai = 0; ai < 2; ++ai)
#pragma unroll
                    for (int m = 0; m < 4; ++m) {
                        f32x4 r0, r1;
#pragma unroll
                        for (int j = 0; j < 4; ++j) { r0[j] = lb0[j] + (1.0f - lb0[j]) * sigmoidf_(acc[ai][bj][m][0][j]); r1[j] = lb1[j] + (1.0f - lb1[j]) * sigmoidf_(acc[ai][bj][m][1][j]); }
                        float* p = LF + (size_t)(row0 + ai * HALF + m * 16) * D + col0 + bj * HALF;
                        *(f32x4*)p = r0; *(f32x4*)(p + 4) = r1;
                    }
            }
        } else {
            f16* dst; int fn, cbase;
            if (pn < 4) { dst = Q; fn = 1; cbase = pn * 256; }
            else if (pn < 12) { dst = V; fn = 0; cbase = (pn - 8) * 256; }
            else if (pn < 16) { dst = SOG; fn = 1; cbase = (pn - 12) * 256; }
            else if (pn < 20) { dst = BG; fn = 0; cbase = (pn - 16) * 256; }
            else if (pn < 32) { dst = SGA; fn = 2; cbase = (pn - 28) * 256; }
            else { dst = SGB; fn = 2; cbase = (pn - 32) * 256; }
            const int col0 = cbase + wc * 32 + 8 * fq;
            if (fn == 0) store_fn<0>(acc, dst, row0, col0); else if (fn == 1) store_fn<1>(acc, dst, row0, col0); else store_fn<2>(acc, dst, row0, col0);
        }
    }
};

typedef const __attribute__((address_space(1))) f16x8* gf16x8p;
template <int NT, int KB, class Epi>
__device__ __forceinline__ void tail_gemm(const f16* A, const f16* Bt, int N, int K, int nmain, int G, int blk, const Epi& E, int wave_s) {
    const int tid = opaque_tid(wave_s), lane = tid & 63, fr = lane & 15, fq = lane >> 4;
    constexpr int RG = NTAIL / 128, UPT = 16 / NT;
    const int ntail = (N / 256) * UPT * RG;
    const int rem = nmain % G, nlight = G - rem;
    if (blk < rem) return;
    for (int u = blk - rem; u < ntail; u += nlight) {
        const int rg = u % RG, cg = u / RG, pn = cg / UPT, jj = cg % UPT;
        const bool pr = Epi::paired(pn);
        const int row = MAIN + 128 * rg + 16 * wave_s + fr;
        int cc[NT];
#pragma unroll
        for (int i = 0; i < NT; ++i) cc[i] = pr ? 256 * pn + 16 * (jj * (NT / 2) + (i >> 1)) + 128 * (i & 1) : 256 * pn + 16 * (jj * NT + i);
        gf16x8p ap = (gf16x8p)(A + (size_t)row * K + 8 * fq);
        gf16x8p bp[NT];
#pragma unroll
        for (int i = 0; i < NT; ++i) bp[i] = (gf16x8p)(Bt + (size_t)(cc[i] + fr) * K + 8 * fq);
        f32x4 acc[NT];
#pragma unroll
        for (int i = 0; i < NT; ++i) acc[i] = (f32x4){0.f, 0.f, 0.f, 0.f};
#pragma unroll 1
        for (int ks = 0; ks < K / 32; ks += KB) {
            f16x8 av[KB], xv[KB][NT];
#pragma unroll
            for (int k = 0; k < KB; ++k) { av[k] = ap[(ks + k) * 4];
#pragma unroll
                for (int i = 0; i < NT; ++i) xv[k][i] = bp[i][(ks + k) * 4]; }
            __builtin_amdgcn_sched_barrier(0);
#pragma unroll
            for (int k = 0; k < KB; ++k)
#pragma unroll
                for (int i = 0; i < NT; ++i) acc[i] = __builtin_amdgcn_mfma_f32_16x16x32_f16(xv[k][i], av[k], acc[i], 0, 0, 0);
            __builtin_amdgcn_sched_barrier(0);
        }
#pragma unroll
        for (int i = 0; i < NT; i += 2) E.tail(row, pn, cc[i] + 4 * fq, cc[i + 1] + 4 * fq, acc[i], acc[i + 1]);
    }
}

template <class Epi>
__device__ __forceinline__ void tail_gemm_lds(LAS unsigned char* lds, const f16* A, const f16* Bt, int N, int K, int G, int blk, const Epi& E, int wave_s) {
    const int tid = opaque_tid(wave_s), lane = tid & 63, fr = lane & 15, fq = lane >> 4;
    constexpr int RS = 272, BUF = 160 * RS, RG = NTAIL / 128;
    const int ntail = (N / 32) * RG, nb = K / 128;
    typedef const __attribute__((address_space(1))) u32x4* gu4p;
    for (int u = blk; u < ntail; u += G) {
        const int rg = u % RG, cg = u / RG, c0 = 32 * cg, row0 = MAIN + 128 * rg;
        gu4p ga[4]; unsigned la[4];
#pragma unroll
        for (int i = 0; i < 4; ++i) { const int idx = tid + 512 * i, r = idx >> 4, ch = idx & 15; ga[i] = (gu4p)(A + (size_t)(row0 + r) * K + 8 * ch); la[i] = (unsigned)(r * RS + 16 * ch); }
        const int rb = tid >> 4, chb = tid & 15;
        gu4p gb = (gu4p)(Bt + (size_t)(c0 + rb) * K + 8 * chb); const unsigned lb = (unsigned)((128 + rb) * RS + 16 * chb);
        u32x4 ra[4], rbv;
#pragma unroll
        for (int i = 0; i < 4; ++i) ra[i] = ga[i][0];
        rbv = gb[0];
        f32x4 acc0 = {0.f, 0.f, 0.f, 0.f}, acc1 = acc0;
        const unsigned aoff = (unsigned)((16 * wave_s + fr) * RS + 16 * fq), boff0 = (unsigned)((128 + fr) * RS + 16 * fq), boff1 = (unsigned)((144 + fr) * RS + 16 * fq);
#pragma unroll 1
        for (int kb = 0; kb < nb; ++kb) {
            LAS unsigned char* buf = lds + (kb & 1) * BUF;
            if constexpr (Epi::HOOK) { if (kb == (nb >> 1)) E.tail_hook(row0 + 16 * wave_s + fr, c0 + 4 * fq, c0 + 16 + 4 * fq, acc0, acc1); }
#pragma unroll
            for (int i = 0; i < 4; ++i) *(LAS u32x4*)(buf + la[i]) = ra[i];
            *(LAS u32x4*)(buf + lb) = rbv;
            if (kb + 1 < nb) {
#pragma unroll
                for (int i = 0; i < 4; ++i) ra[i] = ga[i][(kb + 1) * 16];
                rbv = gb[(kb + 1) * 16]; }
            __syncthreads();
#pragma unroll
            for (int ks = 0; ks < 4; ++ks) { const f16x8 av = *(const LAS f16x8*)(buf + aoff + 64 * ks), x0 = *(const LAS f16x8*)(buf + boff0 + 64 * ks), x1 = *(const LAS f16x8*)(buf + boff1 + 64 * ks);
                acc0 = __builtin_amdgcn_mfma_f32_16x16x32_f16(x0, av, acc0, 0, 0, 0); acc1 = __builtin_amdgcn_mfma_f32_16x16x32_f16(x1, av, acc1, 0, 0, 0); }
        }
        if constexpr (Epi::AFTER_DRAIN) E.tail_fused(rg, cg, wave_s, fr, fq, acc0, acc1, tid); else E.tail(row0 + 16 * wave_s + fr, c0 >> 8, c0 + 4 * fq, c0 + 16 + 4 * fq, acc0, acc1);
    }
    __syncthreads();
}
}

struct Args {
    const float *x_prompt, *x_sample, *state_hgrn, *state_conv, *meta, *w_in, *lb_logits, *norm_w, *conv_w, *w_a, *w_b, *w_o, *gu1, *dn1, *gu2, *dn2, *ln_g, *ln_b;
    float* out; unsigned char* ws;
};

__device__ __forceinline__ float wave_sum(float v) {
#pragma unroll
    for (int o = 1; o < 64; o <<= 1) v += __shfl_xor(v, o);
    return v;
}

__device__ __forceinline__ void p0_transpose_item(const float* W, int K, int N, f16* WT, int ldk, int koff, int dst_row0, LAS float* scr, int k0, int n0, int lane) {
#pragma unroll 8
    for (int i = 0; i < 32; ++i) { const int kk = 2 * i + (lane >> 5); scr[kk * 33 + (lane & 31)] = W[(size_t)(k0 + kk) * N + n0 + (lane & 31)]; }
    LDS_WAIT(); asm volatile("" ::: "memory");
    const int c = lane & 7;
#pragma unroll
    for (int j = 0; j < 4; ++j) { const int n = (lane >> 3) + 8 * j; const LAS float* s = scr + (8 * c) * 33 + n;
        u32x4 o; o.x = pkh(s[0 * 33], s[1 * 33]); o.y = pkh(s[2 * 33], s[3 * 33]); o.z = pkh(s[4 * 33], s[5 * 33]); o.w = pkh(s[6 * 33], s[7 * 33]);
        *(u32x4*)(WT + (size_t)(dst_row0 + n) * ldk + koff + k0 + 8 * c) = o; }
    LDS_WAIT(); asm volatile("" ::: "memory");
}

__device__ __forceinline__ int gu_dst_row(int c) { int j = c, o = 0; if (c >= DFF) { j = c - DFF; o = 128; } return 256 * (j >> 7) + o + (j & 127); }
__device__ __forceinline__ int in_dst_row(int c) { const int seg = c >> 10; if (seg == 5) { const int j = c - 5120; return 5120 + 256 * (j >> 7) + (j & 127); }
    if (seg == 6) { const int j = c - 6144; return 5120 + 256 * (j >> 7) + 128 + (j & 127); } return c; }

__device__ __forceinline__ void p0_prologue(const Args& a, LAS unsigned char* lds, int blk, int G, int wave_s) {
    const int tid = opaque_tid(wave_s), lane = tid & 63, wave = __builtin_amdgcn_readfirstlane(tid >> 6);
    LAS float* scr = (LAS float*)(lds + wave * 16384);
    const int gw = blk * 8 + wave, NGW = G * 8;
    f16* WB = (f16*)(a.ws + WS_W);
    constexpr int I_GU = 16 * 176, I_DN = 44 * 32, I_IN = 16 * 288, I_SQ = 16 * 32, I_LAYER = 2 * I_GU + 2 * I_DN + I_IN + 3 * I_SQ;
    for (int it = gw; it < I_LAYER * NLAYER; it += NGW) {
        const int l = it / I_LAYER; int r = it % I_LAYER;
        f16* wl = WB + (size_t)l * W_LAYER;
        const float* W; int K, N, type; f16* WT; int ldk = 0, koff = 0;
        if (r < I_GU) { W = a.gu1 + (size_t)l * D * 2 * DFF; K = D; N = 2 * DFF; WT = wl + W_GU1; type = 1; }
        else if ((r -= I_GU) < I_DN) { W = a.dn1 + (size_t)l * DFF * D; K = DFF; N = D; WT = wl + W_DN1; type = 0; }
        else if ((r -= I_DN) < I_IN) { W = a.w_in + (size_t)l * D * NIN; K = D; N = NIN; WT = wl + W_IN; type = 2; }
        else if ((r -= I_IN) < I_SQ) { W = a.w_a + (size_t)l * D * D; K = D; N = D; WT = wl + W_A; type = 0; ldk = 2 * D; }
        else if ((r -= I_SQ) < I_SQ) { W = a.w_b + (size_t)l * D * D; K = D; N = D; WT = wl + W_A; type = 0; ldk = 2 * D; koff = D; }
        else if ((r -= I_SQ) < I_SQ) { W = a.w_o + (size_t)l * D * D; K = D; N = D; WT = wl + W_O; type = 0; }
        else if ((r -= I_SQ) < I_GU) { W = a.gu2 + (size_t)l * D * 2 * DFF; K = D; N = 2 * DFF; WT = wl + W_GU2; type = 1; }
        else { r -= I_GU; W = a.dn2 + (size_t)l * DFF * D; K = DFF; N = D; WT = wl + W_DN2; type = 0; }
        const int nblk = N / 32, kb = r / nblk, nb = r % nblk, n0 = nb * 32;
        const int drow = type == 1 ? gu_dst_row(n0) : type == 2 ? in_dst_row(n0) : n0;
        p0_transpose_item(W, K, N, WT, ldk ? ldk : K, koff, drow, scr, kb * 64, n0, lane);
    }
    float* X = (float*)(a.ws + WS_X); f16* XH = (f16*)(a.ws + WS_XH);
    for (int m = MROWS + gw; m < MPAD; m += NGW) {
#pragma unroll
        for (int j = 0; j < 4; ++j) *(u32x2*)(XH + (size_t)m * D + 256 * j + 4 * lane) = (u32x2){0u, 0u};
    }
    for (int m = gw; m < MROWS; m += NGW) {
        const float* src;
        if (m < MAIN) src = a.x_prompt + (size_t)m * D;
        else if (m < SAMP0) src = a.meta + (size_t)((m - META0) & 15) * D;
        else src = a.x_sample + (size_t)(m - SAMP0) * D;
#pragma unroll
        for (int j = 0; j < 4; ++j) { const f32x4 v = *(const f32x4*)(src + 256 * j + 4 * lane);
            u32x2 w; w.x = pkh(v.x, v.y); w.y = pkh(v.z, v.w); *(u32x2*)(XH + (size_t)m * D + 256 * j + 4 * lane) = w; }
    }
    if (blk == 0) {
        float* LB = (float*)(a.ws + WS_LB);
        for (int c = tid; c < D; c += 512) {
            float e[NLAYER], mx = -1e30f, s = 0.f;
            for (int l = 0; l < NLAYER; ++l) { e[l] = a.lb_logits[l * D + c]; mx = fmaxf(mx, e[l]); }
            for (int l = 0; l < NLAYER; ++l) { e[l] = expf(e[l] - mx); s += e[l]; }
            float cum = 0.f;
            LB[c] = 0.f;
            for (int l = 1; l < NLAYER; ++l) { cum += e[l]; LB[l * D + c] = cum / s; }
        }
    }
}

__device__ __forceinline__ void ln_phase(unsigned char* ws, float* out, const float* g, const float* bta, int blk, int G, bool final_, int wave_s) {
    const int tid = opaque_tid(wave_s), lane = tid & 63, wave = tid >> 6;
    const int gw = blk * 8 + wave, NGW = G * 8;
    const f16* X = (const f16*)(ws + WS_X); f16* XH = (f16*)(ws + WS_XH);
    f32x4 gv[4], bv[4];
#pragma unroll
    for (int j = 0; j < 4; ++j) { gv[j] = *(const f32x4*)(g + 256 * j + 4 * lane); bv[j] = *(const f32x4*)(bta + 256 * j + 4 * lane); }
    for (int m = gw; m < MROWS; m += NGW) {
        const f16* xr = X + (size_t)m * D + 4 * lane;
        f32x4 v[4]; float s = 0.f;
#pragma unroll
        for (int j = 0; j < 4; ++j) { const f16x4 hx = *(const f16x4*)(xr + 256 * j); v[j] = (f32x4){(float)hx.x, (float)hx.y, (float)hx.z, (float)hx.w}; s += (v[j].x + v[j].y) + (v[j].z + v[j].w); }
        const float mean = wave_sum(s) * (1.f / D); float s2 = 0.f;
#pragma unroll
        for (int j = 0; j < 4; ++j) { v[j] = v[j] - mean; s2 += (v[j].x * v[j].x + v[j].y * v[j].y) + (v[j].z * v[j].z + v[j].w * v[j].w); }
        const float rstd = 1.0f / sqrtf(wave_sum(s2) * (1.f / D) + LN_EPS);
        if (!final_) {
#pragma unroll
            for (int j = 0; j < 4; ++j) { const f32x4 y = v[j] * rstd * gv[j] + bv[j];
                u32x2 w; w.x = pkh(y.x, y.y); w.y = pkh(y.z, y.w); *(u32x2*)(XH + (size_t)m * D + 256 * j + 4 * lane) = w; }
        } else {
            float* dst = nullptr;
            if (m < MAIN) dst = out + O_YP + (size_t)m * D;
            else if (m >= SAMP0) dst = out + O_YS + (size_t)(m - SAMP0) * D;
            if (dst) {
#pragma unroll
                for (int j = 0; j < 4; ++j) { const f32x4 y = v[j] * rstd * gv[j] + bv[j]; *(f32x4*)(dst + 256 * j + 4 * lane) = y; }
            }
        }
    }
}

constexpr int H_SH = 0, SH_STRIDE = 272, SH_SZ = 32 * SH_STRIDE, H_P = 4 * SH_SZ, P_STRIDE = 48;
constexpr int QS_STRIDE = 272, KT_STRIDE = 144;
constexpr int VT_SZ = 32 * KT_STRIDE, QH_SZ = 64 * QS_STRIDE;
constexpr int H_VT0 = H_P + 64 * P_STRIDE, H_QH0 = H_VT0 + 2 * VT_SZ;
constexpr int H_QB = H_QH0 + 2 * QH_SZ, H_KO = H_QB + 64 * QS_STRIDE, H_KT = H_KO + 64 * QS_STRIDE, H_ES = H_KT + 128 * KT_STRIDE, H_END = H_ES + 2048;
static_assert(H_END <= XB_LDS_OFF && (H_VT0 % 16) == 0 && (H_QH0 % 16) == 0 && (H_QB % 16) == 0 && (H_KT % 16) == 0 && (H_ES % 16) == 0, "hgrn lds map");

__device__ __forceinline__ void hgrn_prompt_item(unsigned char* ws, float* out, LAS unsigned char* lds, int l, int item, int wave_s) {
    const int tid = opaque_tid(wave_s), lane = tid & 63, wave = __builtin_amdgcn_readfirstlane(tid >> 6), fr = lane & 15, fq = lane >> 4;
    const int bh = item >> 2, dvs = item & 3, b = bh >> 3, h = bh & 7;
    const f16* Q = (const f16*)(ws + WS_Q); const float* LF = (const float*)(ws + WS_LF); const f16* V = (const f16*)(ws + WS_V);
    f16* OR = (f16*)(ws + WS_MM); float* SS = (float*)(ws + WS_SS);
    const size_t rowb = (size_t)b * SEQP, rowm = (size_t)META0 + (size_t)b * NMETA;
    f32x4 S[2] = {{0.f, 0.f, 0.f, 0.f}, {0.f, 0.f, 0.f, 0.f}};
    const int ti = wave >> 1, hh = lane >> 5, dp = 32 * (wave & 1) + (lane & 31), tt0 = 16 * ti + 8 * hh;
    f32x2 pF[8]; unsigned pQ2[8]; u32x4 pV;
#define HG_LOAD(c) do { const size_t _rb = (c) == 0 ? rowm : rowb + 64 * ((c) - 1); const int _L = (c) == 0 ? 16 : 64; \
        _Pragma("unroll") for (int k = 0; k < 8; ++k) { pF[k] = (f32x2){1.f, 1.f}; pQ2[k] = 0u; \
            if (tt0 + k < _L) { pF[k] = *(const f32x2*)(LF + (_rb + tt0 + k) * D + 128 * h + 2 * dp); pQ2[k] = *(const unsigned*)(Q + (_rb + tt0 + k) * D + 128 * h + 2 * dp); } } \
        { const int r = tid >> 2, cc = tid & 3; pV = (u32x4){0u, 0u, 0u, 0u}; if (r < _L) pV = *(const u32x4*)(V + (_rb + r) * D + 128 * h + 32 * dvs + 8 * cc); } } while (0)
    HG_LOAD(0);
    constexpr int NCH = 33;
    for (int c = 0; c < NCH; ++c) {
        const size_t rbase = c == 0 ? rowm : rowb + 64 * (c - 1); const int L = c == 0 ? 16 : 64;
        const int H_VT = H_VT0 + (c & 1) * VT_SZ, H_QH = H_QH0 + (c & 1) * QH_SZ;
        if (tid < 256) { const int r = tid >> 2, cc = tid & 3;
#pragma unroll
            for (int e = 0; e < 4; ++e) { const unsigned w = pV[e]; *(LAS unsigned short*)(lds + H_VT + (8 * cc + 2 * e) * KT_STRIDE + 2 * r) = (unsigned short)(w & 0xffffu);
                *(LAS unsigned short*)(lds + H_VT + (8 * cc + 2 * e + 1) * KT_STRIDE + 2 * r) = (unsigned short)(w >> 16); } }
        {
            f32x2 eb[8]; f32x2 run = {1.f, 1.f};
#pragma unroll
            for (int k = 0; k < 8; ++k) { run = run * pF[k]; eb[k] = run; }
            f32x2 oth; oth.x = __shfl_xor(run.x, 32); oth.y = __shfl_xor(run.y, 32);
            const f32x2 bc = run * oth;
            const f32x2 pre = hh ? oth : (f32x2){1.f, 1.f};
            unsigned kt0[4], kt1[4];
#pragma unroll
            for (int k = 0; k < 8; ++k) {
                const f32x2 e = eb[k] * pre; const f16x2 qh2 = __builtin_bit_cast(f16x2, pQ2[k]);
                const f32x2 q = {(float)qh2.x, (float)qh2.y}, kk = (f32x2){1.f, 1.f} - pF[k];
                f32x2 inv; inv.x = __builtin_amdgcn_rcpf(fmaxf(e.x, 1e-30f)); inv.y = __builtin_amdgcn_rcpf(fmaxf(e.y, 1e-30f));
                const f32x2 qh = q * e, ko = kk * inv, ke = ko * bc;
                const int trow = (tt0 + k) * QS_STRIDE + dp * 4;
                *(LAS unsigned*)(lds + H_QH + trow) = pkh(qh.x, qh.y);
                *(LAS unsigned*)(lds + H_QB + trow) = pkb(qh.x, qh.y);
                *(LAS unsigned*)(lds + H_KO + trow) = pkb(ko.x, ko.y);
                const unsigned short h0 = __builtin_bit_cast(unsigned short, (f16)ke.x), h1 = __builtin_bit_cast(unsigned short, (f16)ke.y);
                if (k & 1) { kt0[k >> 1] |= (unsigned)h0 << 16; kt1[k >> 1] |= (unsigned)h1 << 16; } else { kt0[k >> 1] = h0; kt1[k >> 1] = h1; }
            }
            *(LAS u32x4*)(lds + H_KT + (2 * dp) * KT_STRIDE + 2 * tt0) = (u32x4){kt0[0], kt0[1], kt0[2], kt0[3]};
            *(LAS u32x4*)(lds + H_KT + (2 * dp + 1) * KT_STRIDE + 2 * tt0) = (u32x4){kt1[0], kt1[1], kt1[2], kt1[3]};
            if (hh == 0) *(LAS f32x2*)(lds + H_ES + (ti * 128 + 2 * dp) * 4) = bc;
        }
        if (c + 1 < NCH) HG_LOAD(c + 1);
        __syncthreads();
        if (wave < 4) {
            const int i = wave; f32x4 p = {0.f, 0.f, 0.f, 0.f};
#pragma unroll
            for (int ks = 0; ks < 4; ++ks) { const s16x8 qa = *(const LAS s16x8*)(lds + H_QB + (16 * i + fr) * QS_STRIDE + 64 * ks + 16 * fq);
                const s16x8 kb = *(const LAS s16x8*)(lds + H_KO + (16 * i + fr) * QS_STRIDE + 64 * ks + 16 * fq);
                p = __builtin_amdgcn_mfma_f32_16x16x32_bf16(kb, qa, p, 0, 0, 0); }
            u32x2 w; w.x = pkh((4 * fq + 0 <= fr) ? p[0] : 0.f, (4 * fq + 1 <= fr) ? p[1] : 0.f); w.y = pkh((4 * fq + 2 <= fr) ? p[2] : 0.f, (4 * fq + 3 <= fr) ? p[3] : 0.f);
            *(LAS u32x2*)(lds + H_P + (16 * i + fr) * P_STRIDE + 8 * fq) = w;
        }
        {
            const int dd = 16 * wave + fr, d4 = 16 * wave + 4 * fq;
#pragma unroll
            for (int i = 0; i < 4; ++i) {
#pragma unroll
                for (int vt = 0; vt < 2; ++vt) { u32x2 w; w.x = pkh(S[vt][0], S[vt][1]); w.y = pkh(S[vt][2], S[vt][3]);
                    *(LAS u32x2*)(lds + H_SH + i * SH_SZ + (16 * vt + fr) * SH_STRIDE + d4 * 2) = w; }
                const f32x4 sc = *(const LAS f32x4*)(lds + H_ES + (i * 128 + d4) * 4);
                f16x8 kb = {0, 0, 0, 0, 0, 0, 0, 0}, va0 = kb, va1 = kb;
                if (fq < 2) { kb = *(const LAS f16x8*)(lds + H_KT + dd * KT_STRIDE + 32 * i + 16 * fq);
                    va0 = *(const LAS f16x8*)(lds + H_VT + fr * KT_STRIDE + 32 * i + 16 * fq); va1 = *(const LAS f16x8*)(lds + H_VT + (16 + fr) * KT_STRIDE + 32 * i + 16 * fq); }
                S[0] = S[0] * sc; S[1] = S[1] * sc;
                S[0] = __builtin_amdgcn_mfma_f32_16x16x32_f16(kb, va0, S[0], 0, 0, 0);
                S[1] = __builtin_amdgcn_mfma_f32_16x16x32_f16(kb, va1, S[1], 0, 0, 0);
            }
        }
        __syncthreads();
        {
            const int i = wave >> 1, vt = wave & 1; f32x4 o = {0.f, 0.f, 0.f, 0.f};
            f16x8 pa = {0, 0, 0, 0, 0, 0, 0, 0}, vb = pa;
            if (fq < 2) { pa = *(const LAS f16x8*)(lds + H_P + (16 * i + fr) * P_STRIDE + 16 * fq); vb = *(const LAS f16x8*)(lds + H_VT + (16 * vt + fr) * KT_STRIDE + 32 * i + 16 * fq); }
            o = __builtin_amdgcn_mfma_f32_16x16x32_f16(vb, pa, o, 0, 0, 0);
#pragma unroll
            for (int ks = 0; ks < 4; ++ks) { const f16x8 qa = *(const LAS f16x8*)(lds + H_QH + (16 * i + fr) * QS_STRIDE + 64 * ks + 16 * fq);
                const f16x8 sb = *(const LAS f16x8*)(lds + H_SH + i * SH_SZ + (16 * vt + fr) * SH_STRIDE + 64 * ks + 16 * fq);
                o = __builtin_amdgcn_mfma_f32_16x16x32_f16(sb, qa, o, 0, 0, 0); }
            float sq = (o[0] * o[0] + o[1] * o[1]) + (o[2] * o[2] + o[3] * o[3]);
            sq += __shfl_xor(sq, 16); sq += __shfl_xor(sq, 32);
            const int t = 16 * i + fr;
            if (t < L) { const size_t row = rbase + t; u32x2 w; w.x = pkh(o[0], o[1]); w.y = pkh(o[2], o[3]);
                *(u32x2*)(OR + row * D + 128 * h + 32 * dvs + 16 * vt + 4 * fq) = w; if (fq == 0) SS[row * 64 + h * 8 + dvs * 2 + vt] = sq; }
        }
    }
#undef HG_LOAD
    __syncthreads();
    float* outS = out + O_HP + ((((size_t)l * BP + b) * NH + h) * DK + (16 * wave + 4 * fq)) * DV + 32 * dvs + fr;
#pragma unroll
    for (int j = 0; j < 4; ++j) { outS[(size_t)j * DV] = S[0][j]; outS[(size_t)j * DV + 16] = S[1][j]; }
}

__device__ __forceinline__ void hgrn_sample_item(unsigned char* ws, float* out, const float* state_hgrn, LAS unsigned char* lds, int l, int item, int wave_s) {
    const int tid = opaque_tid(wave_s), lane = tid & 63;
    const int bs = item >> 3, h = item & 7;
    const f16* Q = (const f16*)(ws + WS_Q); const float* LF = (const float*)(ws + WS_LF); const f16* V = (const f16*)(ws + WS_V);
    f16* OR = (f16*)(ws + WS_MM); float* SS = (float*)(ws + WS_SS);
    LAS float* sq = (LAS float*)lds; LAS float* sf = sq + 512; LAS float* sk = sf + 512; LAS float* sv = sk + 512; LAS float* red = sv + 512;
    const size_t row0 = (size_t)SAMP0 + (size_t)bs * TS;
    { const int t = tid >> 7, d = tid & 127; const size_t o = (row0 + t) * D + 128 * h + d; const float f = LF[o];
      sq[tid] = (float)Q[o]; sf[tid] = f; sk[tid] = 1.0f - f; sv[tid] = (float)V[o]; }
    const int vq = tid & 31, dg = tid >> 5;
    const size_t sbase = ((((size_t)l * BS + bs) * NH + h) * DK + 8 * dg) * DV + 4 * vq;
    f32x4 S[8];
#pragma unroll
    for (int dd = 0; dd < 8; ++dd) S[dd] = *(const f32x4*)(state_hgrn + sbase + (size_t)dd * DV);
    __syncthreads();
#pragma unroll
    for (int t = 0; t < TS; ++t) {
        const f32x4 vv = *(const LAS f32x4*)(sv + t * 128 + 4 * vq); f32x4 po = {0.f, 0.f, 0.f, 0.f};
#pragma unroll
        for (int dd = 0; dd < 8; ++dd) { const int d = t * 128 + 8 * dg + dd; const float f = sf[d], k = sk[d], q = sq[d]; S[dd] = S[dd] * f + vv * k; po += S[dd] * q; }
        *(LAS f32x4*)(red + (t * 16 + dg) * 128 + 4 * vq) = po;
    }
    __syncthreads();
    { const int t = tid >> 7, v = tid & 127; float o = 0.f;
#pragma unroll
      for (int g = 0; g < 16; ++g) o += red[(t * 16 + g) * 128 + v];
      const size_t row = row0 + t; OR[row * D + 128 * h + v] = (f16)o;
      const float s = wave_sum(o * o);
      if (lane < 4) SS[row * 64 + h * 8 + ((tid >> 6) & 1) * 4 + lane] = lane == 0 ? s : 0.f; }
    float* outS = out + O_HS + sbase;
#pragma unroll
    for (int dd = 0; dd < 8; ++dd) *(f32x4*)(outS + (size_t)dd * DV) = S[dd];
    __syncthreads();
}

__device__ __forceinline__ void mix_post_phase(unsigned char* ws, float* out, const float* norm_w, const float* conv_w, const float* state_conv, int l, int blk, int G, int wave_s) {
    const int tid = opaque_tid(wave_s);
    const f16* O = (const f16*)(ws + WS_MM); const float* SS = (const float*)(ws + WS_SS); const f16* SOG = (const f16*)(ws + WS_SOG);
    const f16* BG = (const f16*)(ws + WS_BG); const f16* U = (const f16*)(ws + WS_U); f16* AB = (f16*)(ws + WS_O);
    const float* nw = norm_w + (size_t)l * DV; const float* cw = conv_w + (size_t)l * 3 * D;
    for (int idx = blk * 512 + tid; idx < MROWS * 128; idx += G * 512) {
        const int row = idx >> 7, c8 = idx & 127, col = 8 * c8, head = c8 >> 4;
        const size_t o = (size_t)row * D + col;
        const f32x4 s0 = *(const f32x4*)(SS + (size_t)row * 64 + head * 8), s1 = *(const f32x4*)(SS + (size_t)row * 64 + head * 8 + 4);
        const float ms = ((s0.x + s0.y) + (s0.z + s0.w) + (s1.x + s1.y) + (s1.z + s1.w)) * (1.f / DV);
        const float r = 1.0f / sqrtf(ms + RMS_EPS);
        const f16x8 ov = *(const f16x8*)(O + o), gv = *(const f16x8*)(SOG + o);
        const f32x4 w0 = *(const f32x4*)(nw + (col & 127)), w1 = *(const f32x4*)(nw + (col & 127) + 4);
        float res[8];
#pragma unroll
        for (int e = 0; e < 8; ++e) res[e] = (float)ov[e] * r * (e < 4 ? w0[e] : w1[e - 4]) * (float)gv[e];
        u32x4 w; w.x = pkh(res[0], res[1]); w.y = pkh(res[2], res[3]); w.z = pkh(res[4], res[5]); w.w = pkh(res[6], res[7]);
        *(u32x4*)(AB + (size_t)row * 2 * D + col) = w;
        int t, T; const float* buf = nullptr; float* nb = nullptr; size_t o1 = o - D, o2 = o - 2 * D;
        if (row < MAIN) { const int b = row >> 11, tp = row & 2047; t = tp + NMETA; T = TP; nb = out + O_CP + ((size_t)l * BP + b) * 2 * D;
            if (tp < 1) o1 = (size_t)(META0 + b * NMETA + 15) * D + col;
            if (tp < 2) o2 = (size_t)(META0 + b * NMETA + 14 + tp) * D + col; }
        else if (row < SAMP0) { t = (row - META0) & 15; T = TP; }
        else { const int bs = (row - SAMP0) >> 2; t = (row - SAMP0) & 3; T = TS; buf = state_conv + ((size_t)l * BS + bs) * 2 * D; nb = out + O_CS + ((size_t)l * BS + bs) * 2 * D; }
        const f16x8 u2 = *(const f16x8*)(U + o);
        float um1[8], um2[8];
#pragma unroll
        for (int e = 0; e < 8; ++e) { um1[e] = 0.f; um2[e] = 0.f; }
        if (t >= 1) { const f16x8 x = *(const f16x8*)(U + o1);
#pragma unroll
            for (int e = 0; e < 8; ++e) um1[e] = (float)x[e]; }
        else if (buf) {
#pragma unroll
            for (int e = 0; e < 8; ++e) um1[e] = buf[D + col + e]; }
        if (t >= 2) { const f16x8 x = *(const f16x8*)(U + o2);
#pragma unroll
            for (int e = 0; e < 8; ++e) um2[e] = (float)x[e]; }
        else if (buf) {
#pragma unroll
            for (int e = 0; e < 8; ++e) um2[e] = buf[(size_t)t * D + col + e]; }
        const f16x8 bg = *(const f16x8*)(BG + o);
        float cr[8];
#pragma unroll
        for (int e = 0; e < 8; ++e) cr[e] = (float)bg[e] * (cw[col + e] * um2[e] + cw[D + col + e] * um1[e] + cw[2 * D + col + e] * (float)u2[e]);
        u32x4 cwv; cwv.x = pkh(cr[0], cr[1]); cwv.y = pkh(cr[2], cr[3]); cwv.z = pkh(cr[4], cr[5]); cwv.w = pkh(cr[6], cr[7]);
        *(u32x4*)(AB + (size_t)row * 2 * D + D + col) = cwv;
        if (t >= T - 2 && nb) { float* p = nb + (size_t)(t - (T - 2)) * D + col;
#pragma unroll
            for (int e = 0; e < 8; ++e) p[e] = (float)u2[e]; }
    }
}

#define XB_TMO      128
#define XB_XCNT(j)  (256  + 64 * (j))
#define XB_XSUB(j)  (1280 + 64 * (j))
#define XB_XGEN(j)  (2304 + 64 * (j))
#define XB_TOP      3328
#define XB_TOPGEN   3392
#define XCD_BAR_WORDS 3456
#define XB_SPIN_CAP (1u << 18)
__device__ __forceinline__ unsigned xb_ld(unsigned* p)              { return __hip_atomic_load(p, __ATOMIC_RELAXED, __HIP_MEMORY_SCOPE_AGENT); }
__device__ __forceinline__ unsigned xb_add(unsigned* p, unsigned v) { return __hip_atomic_fetch_add(p, v, __ATOMIC_RELAXED, __HIP_MEMORY_SCOPE_AGENT); }
__device__ __forceinline__ unsigned xb_xcc_id() { return (unsigned)__builtin_amdgcn_s_getreg((3 << 11) | 20) & 0xFu; }
#define XB_SPIN(cond, bar) do { unsigned _sp = 0; while (cond) { __builtin_amdgcn_s_sleep(1); \
    if ((++_sp & 255u) == 0u) { if (xb_ld(&(bar)[XB_TMO])) break; if (_sp > XB_SPIN_CAP) { atomicAdd(&(bar)[XB_TMO], 1u); break; } } } } while (0)
struct XcdBarrier { unsigned* bar; unsigned x; volatile LAS unsigned* st; };
__device__ __forceinline__ void xcd_barrier_complete(unsigned* bar, unsigned x, unsigned& nloc, unsigned& nx) {
    const unsigned G = gridDim.x * gridDim.y * gridDim.z;
    unsigned sum, cnt, mine, sp = 0u;
    for (;;) {
        sum = 0u; cnt = 0u; mine = 0u;
#pragma unroll
        for (unsigned j = 0; j < 16; ++j) { const unsigned c = xb_ld(&bar[XB_XCNT(j)]); sum += c; cnt += (c > 0u) ? 1u : 0u; mine = (j == x) ? c : mine; }
        if (sum == G) break;
        __builtin_amdgcn_s_sleep(1);
        if ((++sp & 255u) == 0u) { if (xb_ld(&bar[XB_TMO])) break; if (sp > XB_SPIN_CAP) { atomicAdd(&bar[XB_TMO], 1u); break; } }
    }
    nloc = mine > 0u ? mine : 1u; nx = cnt > 0u ? cnt : 1u;
}
__device__ __forceinline__ void xcd_barrier(const XcdBarrier& b, int tid) {
    asm volatile("s_waitcnt vmcnt(0)" ::: "memory");
    __syncthreads();
    if (tid == 0) {
        unsigned* bar = b.bar;
        __builtin_amdgcn_s_waitcnt(0);
        unsigned nloc = b.st[0], nx = b.st[1];
        if (nloc == 0u) { xcd_barrier_complete(bar, b.x, nloc, nx); b.st[0] = nloc; b.st[1] = nx; }
        const unsigned old = xb_add(&bar[XB_XSUB(b.x)], 1u);
        const unsigned gen = old / nloc;
        if (old + 1u == (gen + 1u) * nloc) {
            __builtin_amdgcn_fence(__ATOMIC_RELEASE, "agent");
            asm volatile("s_waitcnt vmcnt(0)" ::: "memory");
            const unsigned og = xb_add(&bar[XB_TOP], 1u);
            const unsigned tg = og / nx;
            if (og + 1u == (tg + 1u) * nx) xb_add(&bar[XB_TOPGEN], 1u);
            else XB_SPIN(xb_ld(&bar[XB_TOPGEN]) == tg, bar);
            __builtin_amdgcn_fence(__ATOMIC_ACQUIRE, "agent");
            xb_add(&bar[XB_XGEN(b.x)], 1u);
            asm volatile("s_waitcnt vmcnt(0)" ::: "memory");
        } else {
            XB_SPIN(xb_ld(&bar[XB_XGEN(b.x)]) == gen, bar);
            __builtin_amdgcn_fence(__ATOMIC_ACQUIRE, "agent");
            asm volatile("s_waitcnt vmcnt(0)" ::: "memory");
        }
    }
    __syncthreads();
}

__global__ void __launch_bounds__(512, 2) mega_fwd(Args a) {
    extern __shared__ __attribute__((aligned(16))) unsigned char lds_raw[];
    LAS unsigned char* lds = (LAS unsigned char*)lds_raw;
#define WSP() karg<19>()
#define LDSP() ({ LAS unsigned char* _p = lds; asm volatile("" : "+s"(_p)); _p; })
    const int blk = blockIdx.x, G = gridDim.x;
    const int vcu = (G % 8 == 0) ? (blk % 8) * (G / 8) + blk / 8 : blk;
    const int wave_s = __builtin_amdgcn_readfirstlane((int)threadIdx.x >> 6);
    volatile LAS unsigned* xst = (volatile LAS unsigned*)(lds + XB_LDS_OFF);
    if (threadIdx.x < 4) xst[threadIdx.x] = 0u;
    __syncthreads();
    XcdBarrier xbar; xbar.bar = (unsigned*)(a.ws + WS_CTL) + 4096; xbar.x = xb_xcc_id(); xbar.st = xst;
    if (threadIdx.x == 0) (void)xb_add(&xbar.bar[XB_XCNT(xbar.x)], 1u);
#define GRID_BAR() do { XcdBarrier _xb; _xb.bar = (unsigned*)(karg<19>() + WS_CTL) + 4096; _xb.x = xb_xcc_id(); _xb.st = (volatile LAS unsigned*)(LDSP() + XB_LDS_OFF); xcd_barrier(_xb, opaque_tid(wave_s)); } while (0)
    p0_prologue(a, lds, vcu, G, wave_s);
    if (a.out == nullptr) { cg::grid_group grid = cg::this_grid(); grid.sync(); }
    GRID_BAR();
    for (int l = 0; l < NLAYER; ++l) {
#define WL() ((const f16*)(WSP() + WS_W) + (size_t)l * W_LAYER)
        pg8::StaticOrder S;
        { unsigned char* ws = WSP(); pg8::Gemm g{(const f16*)(ws + WS_XH), WL() + W_GU1, MPAD, 2 * DFF, D}; S.init(MPAD, 2 * DFF, opaque_s(G), opaque_s(blk)); pg8::EpiGU E{(f16*)(ws + WS_H)}; pg8::gemm_phase(LDSP(), g, S, E, wave_s); }
        GRID_BAR();
        { unsigned char* ws = WSP(); pg8::Gemm g{(const f16*)(ws + WS_H), WL() + W_DN1, MAIN, D, DFF}; S.init(MAIN, D, opaque_s(G), opaque_s(blk)); pg8::EpiResLN E{(const f16*)(ws + WS_XH), (f16*)(ws + WS_XH), ((float*)nullptr), 0.5f, (const float*)karg<16>() + (size_t)l * 3 * D + 0 * D, (const float*)karg<17>() + (size_t)l * 3 * D + 0 * D, ws + WS_X, (unsigned*)(ws + WS_CTL) + CW_PANEL, (unsigned)(l * 3 + 0) + 1u}; pg8::gemm_phase(LDSP(), g, S, E, wave_s);
          pg8::tail_gemm_lds(LDSP(), g.A, g.Bt, g.N, g.K, opaque_s(G), opaque_s(blk), E, wave_s); }
        GRID_BAR();
        { unsigned char* ws = WSP(); pg8::Gemm g{(const f16*)(ws + WS_XH), WL() + W_IN, MPAD, NIN, D}; S.init(MPAD, NIN, opaque_s(G), opaque_s(blk));
          pg8::EpiIn E{(f16*)(ws + WS_Q), (f16*)(ws + WS_V), (f16*)(ws + WS_SOG), (f16*)(ws + WS_BG), (f16*)(ws + WS_U), (f16*)(ws + WS_SGA), (f16*)(ws + WS_SGB),
                       (float*)(ws + WS_LF), (const float*)(ws + WS_LB) + (size_t)l * D};
          pg8::gemm_phase(LDSP(), g, S, E, wave_s); }
        GRID_BAR();
        {
            for (int it = blk; it < 256; it += G) { const int item = ((it & 7) * 8 + (it >> 5)) * 4 + ((it >> 3) & 3); hgrn_prompt_item(WSP(), (float*)karg<18>(), LDSP(), l, item, wave_s); }
            for (int it = blk; it < BS * NH; it += G) hgrn_sample_item(WSP(), (float*)karg<18>(), (const float*)karg<2>(), LDSP(), l, it, wave_s);
        }
        GRID_BAR();
        mix_post_phase(WSP(), (float*)karg<18>(), (const float*)karg<7>(), (const float*)karg<8>(), (const float*)karg<3>(), l, opaque_s(vcu), opaque_s(G), wave_s);
        GRID_BAR();
        { unsigned char* ws = WSP(); pg8::Gemm g{(const f16*)(ws + WS_O), WL() + W_A, MAIN, D, 2 * D}; S.init(MAIN, D, opaque_s(G), opaque_s(blk));
          pg8::EpiMerge E{(const f16*)(ws + WS_SGA), (const f16*)(ws + WS_SGB), (f16*)(ws + WS_MM)}; pg8::gemm_phase(LDSP(), g, S, E, wave_s);
          pg8::tail_gemm_lds(LDSP(), g.A, g.Bt, g.N, g.K, opaque_s(G), opaque_s(blk), E, wave_s); }
        GRID_BAR();
        { unsigned char* ws = WSP(); pg8::Gemm g{(const f16*)(ws + WS_MM), WL() + W_O, MAIN, D, D}; S.init(MAIN, D, opaque_s(G), opaque_s(blk)); pg8::EpiResLN E{(const f16*)(ws + WS_XH), (f16*)(ws + WS_XH), ((float*)nullptr), 1.0f, (const float*)karg<16>() + (size_t)l * 3 * D + 1 * D, (const float*)karg<17>() + (size_t)l * 3 * D + 1 * D, ws + WS_X, (unsigned*)(ws + WS_CTL) + CW_PANEL, (unsigned)(l * 3 + 1) + 1u}; pg8::gemm_phase(LDSP(), g, S, E, wave_s);
          pg8::tail_gemm_lds(LDSP(), g.A, g.Bt, g.N, g.K, opaque_s(G), opaque_s(blk), E, wave_s); }
        GRID_BAR();
        { unsigned char* ws = WSP(); pg8::Gemm g{(const f16*)(ws + WS_XH), WL() + W_GU2, MPAD, 2 * DFF, D}; S.init(MPAD, 2 * DFF, opaque_s(G), opaque_s(blk)); pg8::EpiGU E{(f16*)(ws + WS_H)}; pg8::gemm_phase(LDSP(), g, S, E, wave_s); }
        GRID_BAR();
        { unsigned char* ws = WSP(); pg8::Gemm g{(const f16*)(ws + WS_H), WL() + W_DN2, MAIN, D, DFF}; S.init(MAIN, D, opaque_s(G), opaque_s(blk)); pg8::EpiResLN E{(const f16*)(ws + WS_XH), (f16*)(ws + WS_XH), ((l == NLAYER - 1) ? (float*)karg<18>() + O_YP : (float*)nullptr), 0.5f, (const float*)karg<16>() + (size_t)l * 3 * D + 2 * D, (const float*)karg<17>() + (size_t)l * 3 * D + 2 * D, ws + WS_X, (unsigned*)(ws + WS_CTL) + CW_PANEL, (unsigned)(l * 3 + 2) + 1u}; pg8::gemm_phase(LDSP(), g, S, E, wave_s);
          pg8::tail_gemm_lds(LDSP(), g.A, g.Bt, g.N, g.K, opaque_s(G), opaque_s(blk), E, wave_s); }
        GRID_BAR();
    }
}

extern "C" void kernel_launch(void* const* d_in, const int* in_sizes, int n_in, void* d_out, int out_size, void* d_ws, size_t ws_size, hipStream_t stream) {
    static int inited = 0;
    if (!inited) {
        if (ws_size < WS_END) fprintf(stderr, "kernel_launch: workspace too small: %zu < %zu\n", ws_size, (size_t)WS_END);
        (void)hipFuncSetAttribute((const void*)mega_fwd, hipFuncAttributeMaxDynamicSharedMemorySize, LDS_BYTES);
        inited = 1;
    }
    Args a{};
    a.x_prompt = (const float*)d_in[0]; a.x_sample = (const float*)d_in[1]; a.state_hgrn = (const float*)d_in[2]; a.state_conv = (const float*)d_in[3];
    a.meta = (const float*)d_in[4]; a.w_in = (const float*)d_in[5]; a.lb_logits = (const float*)d_in[6]; a.norm_w = (const float*)d_in[7]; a.conv_w = (const float*)d_in[8];
    a.w_a = (const float*)d_in[9]; a.w_b = (const float*)d_in[10]; a.w_o = (const float*)d_in[11]; a.gu1 = (const float*)d_in[12]; a.dn1 = (const float*)d_in[13];
    a.gu2 = (const float*)d_in[14]; a.dn2 = (const float*)d_in[15]; a.ln_g = (const float*)d_in[16]; a.ln_b = (const float*)d_in[17];
    a.out = (float*)d_out; a.ws = (unsigned char*)d_ws;
    if (hipMemsetAsync((char*)d_ws + WS_CTL, 0, 65536, stream) != hipSuccess) fprintf(stderr, "memset failed\n");
    void* args[] = {&a};
    hipError_t e = hipLaunchCooperativeKernel((const void*)mega_fwd, dim3(256), dim3(512), args, LDS_BYTES, stream);
    if (e != hipSuccess) fprintf(stderr, "cooperative launch failed: %s\n", hipGetErrorString(e));
}
```

```cpp
#include <hip/hip_runtime.h>
#include <hip/hip_cooperative_groups.h>
#include <cstdio>
#include <cstdint>
namespace cg = cooperative_groups;

#define LAS __attribute__((address_space(3)))
typedef _Float16 f16;
typedef _Float16 f16x8 __attribute__((ext_vector_type(8)));
typedef _Float16 f16x4 __attribute__((ext_vector_type(4)));
typedef _Float16 f16x2 __attribute__((ext_vector_type(2)));
typedef short s16x8 __attribute__((ext_vector_type(8)));
typedef float f32x4 __attribute__((ext_vector_type(4)));
typedef float f32x2 __attribute__((ext_vector_type(2)));
typedef unsigned u32x4 __attribute__((ext_vector_type(4)));
typedef unsigned u32x2 __attribute__((ext_vector_type(2)));

constexpr int D = 1024, DFF = 2816, NIN = 9216, NLAYER = 4;
constexpr int BP = 8, TP = 2064, SEQP = 2048, NMETA = 16, MP = BP * TP;
constexpr int BS = 128, TS = 4, MS = BS * TS;
constexpr int MROWS = MP + MS;
constexpr int MAIN = BP * SEQP;
constexpr int META0 = MAIN, SAMP0 = MAIN + BP * NMETA;
constexpr int NTAIL = MROWS - MAIN;
constexpr int MPAD = 17152;
constexpr int NH = 8, DK = 128, DV = 128;
constexpr float ALPHA = 1.6817928305074290f;
constexpr float LN_EPS = 1e-5f, RMS_EPS = 1e-6f;

constexpr size_t O_YP = 0, O_YS = (size_t)BP * SEQP * D, O_HP = O_YS + (size_t)MS * D, O_CP = O_HP + (size_t)NLAYER * BP * NH * DK * DV,
                 O_HS = O_CP + (size_t)NLAYER * BP * 2 * D, O_CS = O_HS + (size_t)NLAYER * BS * NH * DK * DV;

constexpr size_t W_GU1 = 0, W_DN1 = W_GU1 + (size_t)2 * DFF * D, W_IN = W_DN1 + (size_t)D * DFF, W_A = W_IN + (size_t)NIN * D, W_B = W_A + (size_t)D * D,
                 W_O = W_B + (size_t)D * D, W_GU2 = W_O + (size_t)D * D, W_DN2 = W_GU2 + (size_t)2 * DFF * D, W_LAYER = W_DN2 + (size_t)D * DFF;

constexpr size_t AL(size_t x) { return (x + 4095) & ~(size_t)4095; }
constexpr size_t WS_CTL = 0;
constexpr size_t WS_LB = 1u << 20;
constexpr size_t WS_W = WS_LB + 65536;
constexpr size_t WS_X = AL(WS_W + W_LAYER * NLAYER * 2);
constexpr size_t SZ16 = (size_t)MPAD * D * 2, SZ32 = (size_t)MPAD * D * 4;
constexpr size_t WS_XH = AL(WS_X + SZ32);
constexpr size_t WS_Q = AL(WS_XH + SZ16);
constexpr size_t WS_V = WS_Q + SZ16;
constexpr size_t WS_SOG = WS_V + SZ16;
constexpr size_t WS_H = WS_Q;
static_assert((size_t)MPAD * DFF * 2 <= 3 * SZ16, "H overlay");
constexpr size_t WS_LF = AL(WS_SOG + SZ16);
constexpr size_t WS_BG = AL(WS_LF + SZ32);
constexpr size_t WS_U = WS_BG + SZ16;
constexpr size_t WS_SGA = WS_U + SZ16;
constexpr size_t WS_SGB = WS_SGA + SZ16;
constexpr size_t WS_O = WS_SGB + SZ16;
constexpr size_t WS_CB = WS_O + SZ16;
constexpr size_t WS_MM = WS_CB + SZ16;
constexpr size_t WS_SS = AL(WS_MM + SZ16);
constexpr size_t WS_END = WS_SS + (size_t)MPAD * 64 * 4;

constexpr int LDS_BYTES = 147456;
constexpr int XB_LDS_OFF = 147456 - 64;

__device__ __forceinline__ unsigned f2bf(float f) { unsigned u = __builtin_bit_cast(unsigned, f); return (u + 0x7fffu + ((u >> 16) & 1u)) >> 16; }
__device__ __forceinline__ unsigned pkh(float lo, float hi) { f16x2 v = {(f16)lo, (f16)hi}; return __builtin_bit_cast(unsigned, v); }
__device__ __forceinline__ unsigned pkb(float lo, float hi) { unsigned r; asm("v_cvt_pk_bf16_f32 %0, %1, %2" : "=v"(r) : "v"(lo), "v"(hi)); return r; }
__device__ __forceinline__ float sigmoidf_(float x) { return __builtin_amdgcn_rcpf(1.0f + __expf(-x)); }
#define LDS_WAIT() asm volatile("s_waitcnt lgkmcnt(0)" ::: "memory")
__device__ __forceinline__ int opaque_tid(int wave_s) { int t; asm volatile("v_mbcnt_lo_u32_b32 %0, -1, 0\n\tv_mbcnt_hi_u32_b32 %0, -1, %0" : "=v"(t)); return wave_s * 64 + t; }
template <int IDX> __device__ __forceinline__ unsigned char* karg() { __attribute__((address_space(1))) unsigned char* v;
#if defined(__HIP_DEVICE_COMPILE__)
    auto p = __builtin_amdgcn_kernarg_segment_ptr();
    asm volatile("s_load_dwordx2 %0, %1, %2\n\ts_waitcnt lgkmcnt(0)" : "=s"(v) : "s"(p), "n"(IDX * 8));
#else
    v = nullptr;
#endif
    return (unsigned char*)v; }
__device__ __forceinline__ int opaque_s(int x) { asm volatile("" : "+s"(x)); return x; }

__device__ __forceinline__ unsigned pn_ld(unsigned* p)              { return __hip_atomic_load(p, __ATOMIC_RELAXED, __HIP_MEMORY_SCOPE_AGENT); }
__device__ __forceinline__ unsigned pn_add(unsigned* p, unsigned v) { return __hip_atomic_fetch_add(p, v, __ATOMIC_RELAXED, __HIP_MEMORY_SCOPE_AGENT); }
__device__ __forceinline__ void slot_st(f32x2* p, f32x2 v) { __hip_atomic_store((unsigned long long*)p, __builtin_bit_cast(unsigned long long, v), __ATOMIC_RELAXED, __HIP_MEMORY_SCOPE_AGENT); }
__device__ __forceinline__ f32x2 slot_ld(const f32x2* p) { return __builtin_bit_cast(f32x2, __hip_atomic_load((unsigned long long*)p, __ATOMIC_RELAXED, __HIP_MEMORY_SCOPE_AGENT)); }
__device__ __forceinline__ void panel_arrive(unsigned* cnt, int tid) {
    asm volatile("s_waitcnt vmcnt(0)" ::: "memory");
    __syncthreads();
    if (tid == 0) { __builtin_amdgcn_fence(__ATOMIC_RELEASE, "agent"); asm volatile("s_waitcnt vmcnt(0)" ::: "memory"); (void)pn_add(cnt, 1u); }
}
__device__ __forceinline__ void panel_wait(unsigned* cnt, unsigned target, int tid) {
    if (tid == 0) { unsigned sp = 0u; while (pn_ld(cnt) < target) { __builtin_amdgcn_s_sleep(1); if (++sp > (1u << 22)) break; }
        __builtin_amdgcn_fence(__ATOMIC_ACQUIRE, "agent"); asm volatile("s_waitcnt vmcnt(0)" ::: "memory"); }
    __syncthreads();
}
constexpr int CW_PANEL = 8192;
constexpr size_t XS_MAIN = 0, XS_TAIL = 1u << 20;

namespace pg8 {
constexpr int BM = 256, BK = 64, HALF = 128, HTB = HALF * BK * 2, STAGE_BYTES = 8 * HTB, NXCD = 8, WGM = 4;
__host__ __device__ __forceinline__ int lds_byte(int r, int c) { const int st = (r >> 4) * 2 + (c >> 5), rr = r & 15, cc = c & 31, ob = rr * 64 + cc * 2; return st * 1024 + (ob ^ (((ob >> 9) & 1) << 5)); }
__host__ __device__ __forceinline__ void stage_rc(int b, int& R, int& C) { const int st = b / 1024, sb = b % 1024, swz = sb ^ (((sb >> 9) & 1) << 5); R = (st >> 1) * 16 + swz / 64; C = (st & 1) * 32 + (swz % 64) / 2; }
__host__ __device__ __forceinline__ int perm32(int rho) { const int n = rho >> 4, i = rho & 15; return 8 * (i >> 2) + 4 * n + (i & 3); }

struct Unit { int pm, pn; };
struct Gemm { const f16* A; const f16* Bt; int M, N, K; };

struct StaticOrder {
    int nM, nN, nwg, G, c;
    __device__ void init(int M, int N, int G_, int c_) { nM = M / BM; nN = N / BM; nwg = nM * nN; G = G_; c = c_; }
    __device__ bool next(int i, Unit& u) const {
        const long L = (long)i * G + c; if (L >= nwg) return false;
        int wgid = (int)L; { const int q = nwg / NXCD, r = nwg % NXCD, xcd = wgid % NXCD, off = wgid / NXCD; wgid = (xcd < r ? xcd * (q + 1) : r * (q + 1) + (xcd - r) * q) + off; }
        const int nig = WGM * nN, gid = wgid / nig, fm = gid * WGM, gsz = (nM - fm) < WGM ? (nM - fm) : WGM;
        u.pm = fm + ((wgid % nig) % gsz); u.pn = (wgid % nig) / gsz; return true;
    }
};

template <class Epi>
__device__ __forceinline__ void gemm_phase(LAS unsigned char* lds, const Gemm g, const StaticOrder& S, const Epi& E, int wave_s) {
    const int tid = opaque_tid(wave_s), wid = __builtin_amdgcn_readfirstlane(tid >> 6), lane = tid & 63, wr = wid >> 2, wc = wid & 3, fr = lane & 15, fq = lane >> 4;
    const int K = g.K, nt = K / BK;
    unsigned voffA[2], voffB[2];
#pragma unroll
    for (int i = 0; i < 2; ++i) { int R, C; stage_rc(tid * 16 + i * 8192, R, C); const int Rb = Epi::PERM ? ((R & ~31) + perm32(R & 31)) : R;
        voffA[i] = (unsigned)(R * K + C) * 2u; voffB[i] = (unsigned)(Rb * K + C) * 2u; }
    const size_t kstep = (size_t)(BK * 2);
    const size_t hstep = (size_t)HALF * K * 2;
    const size_t tstep = 2 * hstep;
    const unsigned ldsw = (unsigned)wid * 1024u;
    const int aoff = lds_byte(wr * 64 + fr, fq * 8), boff = lds_byte(wc * 32 + fr, fq * 8);
#define PG8_SA(b, h) (((b) * 2 + (h)) * HTB)
#define PG8_SB(b, h) ((4 + (b) * 2 + (h)) * HTB)
#define PG8_STAGE(bufoff, gbase, voff) do { _Pragma("unroll") for (int _i = 0; _i < 2; ++_i) \
        __builtin_amdgcn_global_load_lds((const unsigned*)((const char*)(gbase) + (voff)[_i]), (LAS unsigned*)(lds + (bufoff) + ldsw + _i * 8192), 16, 0, 0); } while (0)
#define PG8_LDA(dst, b, h) do { _Pragma("unroll") for (int m = 0; m < 4; ++m) _Pragma("unroll") for (int k = 0; k < 2; ++k) dst[m][k] = *(const LAS f16x8*)(lds + PG8_SA(b, h) + aoff + m * 2048 + k * 1024); } while (0)
#define PG8_LDB(dst, b, h) do { _Pragma("unroll") for (int n = 0; n < 2; ++n) _Pragma("unroll") for (int k = 0; k < 2; ++k) dst[n][k] = *(const LAS f16x8*)(lds + PG8_SB(b, h) + boff + n * 2048 + k * 1024); } while (0)
#define PG8_MMA(ai, bj, At, Bt) do { __builtin_amdgcn_s_setprio(1); _Pragma("unroll") for (int m = 0; m < 4; ++m) _Pragma("unroll") for (int n = 0; n < 2; ++n) _Pragma("unroll") for (int k = 0; k < 2; ++k) \
        acc[ai][bj][m][n] = __builtin_amdgcn_mfma_f32_16x16x32_f16(Bt[n][k], At[m][k], acc[ai][bj][m][n], 0, 0, 0); __builtin_amdgcn_s_setprio(0); } while (0)
#define PG8_WAIT_V(n) asm volatile("s_waitcnt vmcnt(" #n ")" ::: "memory")
#define PG8_WAIT_L(n) asm volatile("s_waitcnt lgkmcnt(" #n ")" ::: "memory")
#define PG8_BAR __builtin_amdgcn_s_barrier()
#define PG8_SCHED __builtin_amdgcn_sched_barrier(0)
    Unit cur, nxt; int ui = 0;
    if (!S.next(0, cur)) return;
    f32x4 acc[2][2][4][2];
#pragma unroll
    for (int a = 0; a < 2; ++a)
#pragma unroll
        for (int b = 0; b < 2; ++b)
#pragma unroll
            for (int m = 0; m < 4; ++m)
#pragma unroll
                for (int n = 0; n < 2; ++n) acc[a][b][m][n] = (f32x4){0.f, 0.f, 0.f, 0.f};
    f16x8 At[4][2], B0[2][2], B1[2][2];
    const char* cA = (const char*)g.A + (size_t)cur.pm * tstep; const char* cB = (const char*)g.Bt + (size_t)cur.pn * tstep;
    PG8_STAGE(PG8_SB(0, 0), cB, voffB); PG8_STAGE(PG8_SB(0, 1), cB + hstep, voffB); PG8_STAGE(PG8_SA(0, 0), cA, voffA); PG8_STAGE(PG8_SA(0, 1), cA + hstep, voffA);
    if (wr == 1) PG8_BAR;
    PG8_WAIT_V(2); PG8_BAR;
    PG8_STAGE(PG8_SB(1, 0), cB + kstep, voffB); PG8_STAGE(PG8_SA(1, 0), cA + kstep, voffA); PG8_STAGE(PG8_SB(1, 1), cB + hstep + kstep, voffB);
    PG8_WAIT_V(6); PG8_BAR;
    for (;;) {
        const bool has_next = S.next(ui + 1, nxt);
        const char* nA = has_next ? (const char*)g.A + (size_t)nxt.pm * tstep : cA; const char* nB = has_next ? (const char*)g.Bt + (size_t)nxt.pn * tstep : cB;
#define PG8_KBODY \
            const bool last = (t == nt - 2); \
            const char* a1 = cA + (size_t)(t + 1) * kstep; \
            const char* a2 = last ? nA : cA + (size_t)(t + 2) * kstep; const char* b2 = last ? nB : cB + (size_t)(t + 2) * kstep; \
            const char* a3 = a2 + kstep; const char* b3 = b2 + kstep; \
            PG8_LDB(B0, 0, 0); PG8_LDB(B1, 0, 1); PG8_SCHED; PG8_LDA(At, 0, 0); PG8_STAGE(PG8_SA(1, 1), a1 + hstep, voffA); \
            PG8_WAIT_V(8); PG8_WAIT_L(0); PG8_BAR; PG8_MMA(0, 0, At, B0); PG8_MMA(0, 1, At, B1); PG8_BAR; PG8_SCHED; \
            PG8_LDA(At, 0, 1); PG8_STAGE(PG8_SB(0, 0), b2, voffB); PG8_STAGE(PG8_SB(0, 1), b2 + hstep, voffB); PG8_STAGE(PG8_SA(0, 0), a2, voffA); \
            PG8_WAIT_V(8); PG8_WAIT_L(0); PG8_BAR; PG8_MMA(1, 0, At, B0); PG8_MMA(1, 1, At, B1); PG8_BAR; PG8_SCHED; \
            PG8_LDB(B0, 1, 0); PG8_LDB(B1, 1, 1); PG8_SCHED; PG8_LDA(At, 1, 0); PG8_STAGE(PG8_SA(0, 1), a2 + hstep, voffA); \
            PG8_WAIT_V(8); PG8_WAIT_L(0); PG8_BAR; PG8_MMA(0, 0, At, B0); PG8_MMA(0, 1, At, B1); PG8_BAR; PG8_SCHED; \
            PG8_LDA(At, 1, 1); PG8_STAGE(PG8_SB(1, 0), b3, voffB); PG8_STAGE(PG8_SB(1, 1), b3 + hstep, voffB); PG8_STAGE(PG8_SA(1, 0), a3, voffA); \
            PG8_WAIT_V(8); PG8_WAIT_L(0); PG8_BAR; PG8_MMA(1, 0, At, B0); PG8_MMA(1, 1, At, B1); PG8_BAR; PG8_SCHED;
        if constexpr (Epi::HOOK) {
            for (int t = 0; t < (nt >> 1); t += 2) { PG8_KBODY }
            E.hook(acc, cur, wr, wc, fr, fq);
            for (int t = (nt >> 1); t < nt; t += 2) { PG8_KBODY }
        } else {
            for (int t = 0; t < nt; t += 2) { PG8_KBODY }
        }
#undef PG8_KBODY
        if (wr == 0) PG8_BAR;
        if constexpr (!Epi::AFTER_DRAIN) E(acc, cur, wr, wc, fr, fq);
        if (!has_next) break;
#pragma unroll
        for (int a = 0; a < 2; ++a)
#pragma unroll
            for (int b = 0; b < 2; ++b)
#pragma unroll
                for (int m = 0; m < 4; ++m)
#pragma unroll
                    for (int n = 0; n < 2; ++n) acc[a][b][m][n] = (f32x4){0.f, 0.f, 0.f, 0.f};
        cur = nxt; cA = nA; cB = nB; ++ui;
        if (wr == 1) PG8_BAR;
    }
    PG8_WAIT_V(0);
    PG8_BAR;
    if constexpr (Epi::AFTER_DRAIN) E.fused(acc, cur, wr, wc, fr, fq, lds, tid);
#undef PG8_SA
#undef PG8_SB
#undef PG8_STAGE
#undef PG8_LDA
#undef PG8_LDB
#undef PG8_MMA
#undef PG8_WAIT_V
#undef PG8_WAIT_L
#undef PG8_BAR
#undef PG8_SCHED
}

struct EpiGU {
    static constexpr bool PERM = true, HOOK = false, AFTER_DRAIN = false;
    f16* H;
    __device__ __forceinline__ static bool paired(int) { return true; }
    __device__ __forceinline__ void tail(int row, int pn, int cc0, int cc1, const f32x4& v0, const f32x4& v1) const {
        float h[4];
#pragma unroll
        for (int j = 0; j < 4; ++j) h[j] = v0[j] * sigmoidf_(v0[j]) * v1[j];
        u32x2 w; w.x = pkh(h[0], h[1]); w.y = pkh(h[2], h[3]); *(u32x2*)(H + (size_t)row * DFF + (cc0 - 128 * pn)) = w;
    }
    __device__ __forceinline__ void operator()(const f32x4 (&acc)[2][2][4][2], const Unit& u, int wr, int wc, int fr, int fq) const {
        const int row0 = u.pm * BM + wr * 64 + fr, col0 = u.pn * 128 + wc * 32 + 8 * fq;
#pragma unroll
        for (int ai = 0; ai < 2; ++ai)
#pragma unroll
            for (int m = 0; m < 4; ++m) {
                float h[8];
#pragma unroll
                for (int n = 0; n < 2; ++n)
#pragma unroll
                    for (int j = 0; j < 4; ++j) { const float gv = acc[ai][0][m][n][j], uv = acc[ai][1][m][n][j]; h[n * 4 + j] = gv * sigmoidf_(gv) * uv; }
                u32x4 w; w.x = pkh(h[0], h[1]); w.y = pkh(h[2], h[3]); w.z = pkh(h[4], h[5]); w.w = pkh(h[6], h[7]);
                *(u32x4*)(H + (size_t)(row0 + ai * HALF + m * 16) * DFF + col0) = w;
            }
    }
};
struct EpiResLN {
    static constexpr bool PERM = false, HOOK = false, AFTER_DRAIN = true;
    const f16* XHr; f16* XHw; float* outp; float scale; const float* gam; const float* bet; unsigned char* xs; unsigned* cnt; unsigned inst;
    __device__ __forceinline__ static bool paired(int) { return false; }
    __device__ __forceinline__ void operator()(const f32x4 (&)[2][2][4][2], const Unit&, int, int, int, int) const {}
    __device__ __forceinline__ void fused(f32x4 (&acc)[2][2][4][2], const Unit& u, int wr, int wc, int fr, int fq, LAS unsigned char* lds, int tid) const {
        const int rt0 = wr * 64 + fr, col0 = u.pn * BM + wc * 32 + 4 * fq;
        LAS f32x2* P = (LAS f32x2*)lds; LAS f32x2* ST = (LAS f32x2*)(lds + 8192);
        {
            const f16* px = XHr + (size_t)(u.pm * BM + rt0) * D + col0;
#pragma unroll
            for (int ai = 0; ai < 2; ++ai) {
#pragma unroll
                for (int m = 0; m < 4; ++m) {
                    asm volatile("" : "+v"(px));
                    float sm = 0.f, sq = 0.f;
#pragma unroll
                    for (int bj = 0; bj < 2; ++bj)
#pragma unroll
                        for (int n = 0; n < 2; ++n) { const f16x4 h = *(const f16x4*)(px + bj * HALF + n * 16);
#pragma unroll
                            for (int j = 0; j < 4; ++j) { const float t = (float)h[j] * ALPHA + acc[ai][bj][m][n][j] * scale; acc[ai][bj][m][n][j] = t; sm += t; sq += t * t; } }
                    sm += __shfl_xor(sm, 16); sm += __shfl_xor(sm, 32); sq += __shfl_xor(sq, 16); sq += __shfl_xor(sq, 32);
                    if (fq == 0) P[(ai * HALF + m * 16 + rt0) * 4 + wc] = (f32x2){sm, sq};
                    px += 16 * D;
                    __builtin_amdgcn_sched_barrier(0);
                }
                px += 64 * D;
            }
        }
        __syncthreads();
        f32x2* slot = (f32x2*)(xs + XS_MAIN) + (size_t)(u.pm * 256) * 4;
        if (tid < 256) { const f32x2 a = P[tid * 4 + 0], b = P[tid * 4 + 1], c = P[tid * 4 + 2], d = P[tid * 4 + 3];
            slot_st(slot + u.pn * 256 + tid, (f32x2){(a.x + b.x) + (c.x + d.x), (a.y + b.y) + (c.y + d.y)}); }
        panel_arrive(cnt + 64 * u.pm, tid);
        panel_wait(cnt + 64 * u.pm, 4u * inst, tid);
        if (tid < 256) { const f32x2 a = slot_ld(slot + tid), b = slot_ld(slot + 256 + tid), c = slot_ld(slot + 512 + tid), d = slot_ld(slot + 768 + tid);
            const float mean = ((a.x + b.x) + (c.x + d.x)) * (1.f / D), ex2 = ((a.y + b.y) + (c.y + d.y)) * (1.f / D);
            ST[tid] = (f32x2){mean, 1.0f / sqrtf(fmaxf(ex2 - mean * mean, 0.f) + LN_EPS)}; }
        __syncthreads();
        {
            f32x4 gv[2][2], bv[2][2];
#pragma unroll
            for (int bj = 0; bj < 2; ++bj)
#pragma unroll
                for (int n = 0; n < 2; ++n) { gv[bj][n] = *(const f32x4*)(gam + col0 + bj * HALF + n * 16); bv[bj][n] = *(const f32x4*)(bet + col0 + bj * HALF + n * 16); }
            size_t ro = (size_t)(u.pm * BM + rt0) * D + col0;
#pragma unroll
            for (int ai = 0; ai < 2; ++ai) {
#pragma unroll
                for (int m = 0; m < 4; ++m) {
                    asm volatile("" : "+v"(ro));
                    const f32x2 st = ST[ai * HALF + m * 16 + rt0];
#pragma unroll
                    for (int bj = 0; bj < 2; ++bj)
#pragma unroll
                        for (int n = 0; n < 2; ++n) { const f32x4 y = (acc[ai][bj][m][n] - st.x) * st.y * gv[bj][n] + bv[bj][n];
                            if (outp) *(f32x4*)(outp + ro + bj * HALF + n * 16) = y;
                            else { u32x2 w; w.x = pkh(y.x, y.y); w.y = pkh(y.z, y.w); *(u32x2*)(XHw + ro + bj * HALF + n * 16) = w; } }
                    ro += 16 * D;
                }
                ro += 64 * D;
            }
        }
        __syncthreads();
    }
    __device__ __forceinline__ void tail(int, int, int, int, const f32x4&, const f32x4&) const {}
    __device__ __forceinline__ void tail_fused(int rg, int cg, int wave_s, int fr, int fq, f32x4 v0, f32x4 v1, int tid) const {
        const int rin = 16 * wave_s + fr, row = MAIN + 128 * rg + rin, c0 = 32 * cg + 4 * fq, c1 = c0 + 16;
        const size_t o0 = (size_t)row * D + c0, o1 = (size_t)row * D + c1;
        const f16x4 h0 = *(const f16x4*)(XHr + o0), h1 = *(const f16x4*)(XHr + o1);
        float sm = 0.f, sq = 0.f;
#pragma unroll
        for (int j = 0; j < 4; ++j) { v0[j] = (float)h0[j] * ALPHA + v0[j] * scale; v1[j] = (float)h1[j] * ALPHA + v1[j] * scale; sm += v0[j] + v1[j]; sq += v0[j] * v0[j] + v1[j] * v1[j]; }
        sm += __shfl_xor(sm, 16); sm += __shfl_xor(sm, 32); sq += __shfl_xor(sq, 16); sq += __shfl_xor(sq, 32);
        f32x2* slot = (f32x2*)(xs + XS_TAIL) + (size_t)(rg * 128) * 32;
        if (fq == 0) slot_st(slot + cg * 128 + rin, (f32x2){sm, sq});
        panel_arrive(cnt + 64 * (64 + rg), tid);
        panel_wait(cnt + 64 * (64 + rg), 32u * inst, tid);
        float ts = 0.f, tq = 0.f;
#pragma unroll
        for (int k = 0; k < 8; ++k) { const f32x2 p = slot_ld(slot + (fq * 8 + k) * 128 + rin); ts += p.x; tq += p.y; }
        ts += __shfl_xor(ts, 16); ts += __shfl_xor(ts, 32); tq += __shfl_xor(tq, 16); tq += __shfl_xor(tq, 32);
        const float mean = ts * (1.f / D), rstd = 1.0f / sqrtf(fmaxf(tq * (1.f / D) - mean * mean, 0.f) + LN_EPS);
        const f32x4 g0 = *(const f32x4*)(gam + c0), g1 = *(const f32x4*)(gam + c1), b0 = *(const f32x4*)(bet + c0), b1 = *(const f32x4*)(bet + c1);
        const f32x4 y0 = (v0 - mean) * rstd * g0 + b0, y1 = (v1 - mean) * rstd * g1 + b1;
        if (outp) { if (row >= SAMP0) { float* d = outp + (O_YS - O_YP) + (size_t)(row - SAMP0) * D; *(f32x4*)(d + c0) = y0; *(f32x4*)(d + c1) = y1; } }
        else { u32x2 w0, w1; w0.x = pkh(y0.x, y0.y); w0.y = pkh(y0.z, y0.w); w1.x = pkh(y1.x, y1.y); w1.y = pkh(y1.z, y1.w); *(u32x2*)(XHw + o0) = w0; *(u32x2*)(XHw + o1) = w1; }
    }
};
struct EpiMerge {
    static constexpr bool PERM = false, HOOK = true, AFTER_DRAIN = false;
    const f16* SGA; const f16* SGB; f16* MM;
    __device__ __forceinline__ static bool paired(int) { return false; }
    __device__ __forceinline__ static float ratio(f16 a, f16 b) { return (float)a * __builtin_amdgcn_rcpf(fmaxf((float)b, 1e-4f)); }
    __device__ __forceinline__ void tail_hook(int row, int cc0, int cc1, f32x4& v0, f32x4& v1) const {
        const size_t o0 = (size_t)row * D + cc0, o1 = (size_t)row * D + cc1;
        const f16x4 a0 = *(const f16x4*)(SGA + o0), a1 = *(const f16x4*)(SGA + o1), b0 = *(const f16x4*)(SGB + o0), b1 = *(const f16x4*)(SGB + o1);
#pragma unroll
        for (int j = 0; j < 4; ++j) { v0[j] *= ratio(a0[j], b0[j]); v1[j] *= ratio(a1[j], b1[j]); }
    }
    __device__ __forceinline__ void tail(int row, int pn, int cc0, int cc1, const f32x4& v0, const f32x4& v1) const {
        const size_t o0 = (size_t)row * D + cc0, o1 = (size_t)row * D + cc1; const f16x4 g0 = *(const f16x4*)(SGB + o0), g1 = *(const f16x4*)(SGB + o1);
        float r0[4], r1[4];
#pragma unroll
        for (int j = 0; j < 4; ++j) { r0[j] = v0[j] * fmaxf((float)g0[j], 1e-4f); r1[j] = v1[j] * fmaxf((float)g1[j], 1e-4f); }
        u32x2 w0, w1; w0.x = pkh(r0[0], r0[1]); w0.y = pkh(r0[2], r0[3]); w1.x = pkh(r1[0], r1[1]); w1.y = pkh(r1[2], r1[3]);
        *(u32x2*)(MM + o0) = w0; *(u32x2*)(MM + o1) = w1;
    }
    __device__ __forceinline__ void hook(f32x4 (&acc)[2][2][4][2], const Unit& u, int wr, int wc, int fr, int fq) const {
        const int row0 = u.pm * BM + wr * 64 + fr, col0 = u.pn * BM + wc * 32 + 4 * fq;
        const f16* pa = SGA + (size_t)row0 * D + col0; const f16* pb = SGB + (size_t)row0 * D + col0;
#pragma unroll
        for (int ai = 0; ai < 2; ++ai) {
#pragma unroll
            for (int m = 0; m < 4; ++m) {
                asm volatile("" : "+v"(pa), "+v"(pb));
#pragma unroll
                for (int bj = 0; bj < 2; ++bj)
#pragma unroll
                    for (int n = 0; n < 2; ++n) { const f16x4 ga = *(const f16x4*)(pa + bj * HALF + n * 16), gb = *(const f16x4*)(pb + bj * HALF + n * 16);
#pragma unroll
                        for (int j = 0; j < 4; ++j) acc[ai][bj][m][n][j] *= ratio(ga[j], gb[j]); }
                pa += 16 * D; pb += 16 * D;
                __builtin_amdgcn_sched_barrier(0);
            }
            pa += 64 * D; pb += 64 * D;
        }
    }
    __device__ __forceinline__ void operator()(const f32x4 (&acc)[2][2][4][2], const Unit& u, int wr, int wc, int fr, int fq) const {
        const int row0 = u.pm * BM + wr * 64 + fr, col0 = u.pn * BM + wc * 32 + 4 * fq;
#pragma unroll
        for (int ai = 0; ai < 2; ++ai)
#pragma unroll
            for (int m = 0; m < 4; ++m) { const size_t ro = (size_t)(row0 + ai * HALF + m * 16) * D + col0;
#pragma unroll
                for (int bj = 0; bj < 2; ++bj)
#pragma unroll
                    for (int n = 0; n < 2; ++n) { const size_t o = ro + bj * HALF + n * 16; const f16x4 gq = *(const f16x4*)(SGB + o);
                        u32x2 w; w.x = pkh(acc[ai][bj][m][n].x * fmaxf((float)gq.x, 1e-4f), acc[ai][bj][m][n].y * fmaxf((float)gq.y, 1e-4f));
                        w.y = pkh(acc[ai][bj][m][n].z * fmaxf((float)gq.z, 1e-4f), acc[ai][bj][m][n].w * fmaxf((float)gq.w, 1e-4f));
                        *(u32x2*)(MM + o) = w; } }
    }
};
struct EpiIn {
    static constexpr bool PERM = true, HOOK = false, AFTER_DRAIN = false;
    f16 *Q, *V, *SOG, *BG, *U, *SGA, *SGB; float* LF; const float* LB;
    __device__ __forceinline__ static bool paired(int pn) { return pn >= 20 && pn < 28; }
    template <int FN> __device__ __forceinline__ static void store_fn(const f32x4 (&acc)[2][2][4][2], f16* dst, int row0, int col0) {
#pragma unroll
        for (int ai = 0; ai < 2; ++ai)
#pragma unroll
            for (int m = 0; m < 4; ++m)
#pragma unroll
                for (int bj = 0; bj < 2; ++bj) {
                    float h[8];
#pragma unroll
                    for (int n = 0; n < 2; ++n)
#pragma unroll
                        for (int j = 0; j < 4; ++j) { const float x = acc[ai][bj][m][n][j]; float r = x;
                            if (FN != 0) { const float sg = sigmoidf_(x); r = (FN == 1) ? x * sg : sg; }
                            h[n * 4 + j] = r; }
                    u32x4 w; w.x = pkh(h[0], h[1]); w.y = pkh(h[2], h[3]); w.z = pkh(h[4], h[5]); w.w = pkh(h[6], h[7]);
                    *(u32x4*)(dst + (size_t)(row0 + ai * HALF + m * 16) * D + col0 + bj * HALF) = w;
                }
    }
    __device__ __forceinline__ void tail1(int row, int pn, int cc, const f32x4& v) const {
        const int cl = cc - 256 * pn;
        if (pn >= 4 && pn < 8) { const int col = (pn - 4) * 256 + cl; const f32x4 lb = *(const f32x4*)(LB + col); f32x4 r;
#pragma unroll
            for (int j = 0; j < 4; ++j) r[j] = lb[j] + (1.0f - lb[j]) * sigmoidf_(v[j]);
            *(f32x4*)(LF + (size_t)row * D + col) = r; return; }
        f16* dst; int fn, cbase;
        if (pn < 4) { dst = Q; fn = 1; cbase = pn * 256; }
        else if (pn < 12) { dst = V; fn = 0; cbase = (pn - 8) * 256; }
        else if (pn < 16) { dst = SOG; fn = 1; cbase = (pn - 12) * 256; }
        else if (pn < 20) { dst = BG; fn = 0; cbase = (pn - 16) * 256; }
        else if (pn < 32) { dst = SGA; fn = 2; cbase = (pn - 28) * 256; }
        else { dst = SGB; fn = 2; cbase = (pn - 32) * 256; }
        float h[4];
#pragma unroll
        for (int j = 0; j < 4; ++j) { const float x = v[j]; float r = x; if (fn != 0) { const float sg = sigmoidf_(x); r = (fn == 1) ? x * sg : sg; } h[j] = r; }
        u32x2 w; w.x = pkh(h[0], h[1]); w.y = pkh(h[2], h[3]); *(u32x2*)(dst + (size_t)row * D + cbase + cl) = w;
    }
    __device__ __forceinline__ void tail(int row, int pn, int cc0, int cc1, const f32x4& v0, const f32x4& v1) const {
        if (pn >= 20 && pn < 28) { u32x2 w; w.x = pkh(v0[0] * v1[0], v0[1] * v1[1]); w.y = pkh(v0[2] * v1[2], v0[3] * v1[3]);
            *(u32x2*)(U + (size_t)row * D + (pn - 20) * 128 + (cc0 - 256 * pn)) = w; return; }
        tail1(row, pn, cc0, v0); tail1(row, pn, cc1, v1);
    }
    __device__ __forceinline__ void operator()(const f32x4 (&acc)[2][2][4][2], const Unit& u, int wr, int wc, int fr, int fq) const {
        const int row0 = u.pm * BM + wr * 64 + fr, pn = u.pn;
        if (pn >= 20 && pn < 28) {
            const int col0 = (pn - 20) * 128 + wc * 32 + 8 * fq;
#pragma unroll
            for (int ai = 0; ai < 2; ++ai)
#pragma unroll
                for (int m = 0; m < 4; ++m) {
                    float h[8];
#pragma unroll
                    for (int n = 0; n < 2; ++n)
#pragma unroll
                        for (int j = 0; j < 4; ++j) h[n * 4 + j] = acc[ai][0][m][n][j] * acc[ai][1][m][n][j];
                    u32x4 w; w.x = pkh(h[0], h[1]); w.y = pkh(h[2], h[3]); w.z = pkh(h[4], h[5]); w.w = pkh(h[6], h[7]);
                    *(u32x4*)(U + (size_t)(row0 + ai * HALF + m * 16) * D + col0) = w;
                }
        } else if (pn >= 4 && pn < 8) {
            const int col0 = (pn - 4) * 256 + wc * 32 + 8 * fq;
#pragma unroll
            for (int bj = 0; bj < 2; ++bj) {
                const f32x4 lb0 = *(const f32x4*)(LB + col0 + bj * HALF), lb1 = *(const f32x4*)(LB + col0 + bj * HALF + 4);
#pragma unroll
                for (int ai = 0; ai < 2; ++ai)
#pragma unroll
                    for (int m = 0; m < 4; ++m) {
                        f32x4 r0, r1;
#pragma unroll
                        for (int j = 0; j < 4; ++j) { r0[j] = lb0[j] + (1.0f - lb0[j]) * sigmoidf_(acc[ai][bj][m][0][j]); r1[j] = lb1[j] + (1.0f - lb1[j]) * sigmoidf_(acc[ai][bj][m][1][j]); }
                        float* p = LF + (size_t)(row0 + ai * HALF + m * 16) * D + col0 + bj * HALF;
                        *(f32x4*)p = r0; *(f32x4*)(p + 4) = r1;
                    }
            }
        } else {
            f16* dst; int fn, cbase;
            if (pn < 4) { dst = Q; fn = 1; cbase = pn * 256; }
            else if (pn < 12) { dst = V; fn = 0; cbase = (pn - 8) * 256; }
            else if (pn < 16) { dst = SOG; fn = 1; cbase = (pn - 12) * 256; }
            else if (pn < 20) { dst = BG; fn = 0; cbase = (pn - 16) * 256; }
            else if (pn < 32) { dst = SGA; fn = 2; cbase = (pn - 28) * 256; }
            else { dst = SGB; fn = 2; cbase = (pn - 32) * 256; }
            const int col0 = cbase + wc * 32 + 8 * fq;
            if (fn == 0) store_fn<0>(acc, dst, row0, col0); else if (fn == 1) store_fn<1>(acc, dst, row0, col0); else store_fn<2>(acc, dst, row0, col0);
        }
    }
};

typedef const __attribute__((address_space(1))) f16x8* gf16x8p;
template <int NT, int KB, class Epi>
__device__ __forceinline__ void tail_gemm(const f16* A, const f16* Bt, int N, int K, int nmain, int G, int blk, const Epi& E, int wave_s) {
    const int tid = opaque_tid(wave_s), lane = tid & 63, fr = lane & 15, fq = lane >> 4;
    constexpr int RG = NTAIL / 128, UPT = 16 / NT;
    const int ntail = (N / 256) * UPT * RG;
    const int rem = nmain % G, nlight = G - rem;
    if (blk < rem) return;
    for (int u = blk - rem; u < ntail; u += nlight) {
        const int rg = u % RG, cg = u / RG, pn = cg / UPT, jj = cg % UPT;
        const bool pr = Epi::paired(pn);
        const int row = MAIN + 128 * rg + 16 * wave_s + fr;
        int cc[NT];
#pragma unroll
        for (int i = 0; i < NT; ++i) cc[i] = pr ? 256 * pn + 16 * (jj * (NT / 2) + (i >> 1)) + 128 * (i & 1) : 256 * pn + 16 * (jj * NT + i);
        gf16x8p ap = (gf16x8p)(A + (size_t)row * K + 8 * fq);
        gf16x8p bp[NT];
#pragma unroll
        for (int i = 0; i < NT; ++i) bp[i] = (gf16x8p)(Bt + (size_t)(cc[i] + fr) * K + 8 * fq);
        f32x4 acc[NT];
#pragma unroll
        for (int i = 0; i < NT; ++i) acc[i] = (f32x4){0.f, 0.f, 0.f, 0.f};
#pragma unroll 1
        for (int ks = 0; ks < K / 32; ks += KB) {
            f16x8 av[KB], xv[KB][NT];
#pragma unroll
            for (int k = 0; k < KB; ++k) { av[k] = ap[(ks + k) * 4];
#pragma unroll
                for (int i = 0; i < NT; ++i) xv[k][i] = bp[i][(ks + k) * 4]; }
            __builtin_amdgcn_sched_barrier(0);
#pragma unroll
            for (int k = 0; k < KB; ++k)
#pragma unroll
                for (int i = 0; i < NT; ++i) acc[i] = __builtin_amdgcn_mfma_f32_16x16x32_f16(xv[k][i], av[k], acc[i], 0, 0, 0);
            __builtin_amdgcn_sched_barrier(0);
        }
#pragma unroll
        for (int i = 0; i < NT; i += 2) E.tail(row, pn, cc[i] + 4 * fq, cc[i + 1] + 4 * fq, acc[i], acc[i + 1]);
    }
}

template <class Epi>
__device__ __forceinline__ void tail_gemm_lds(LAS unsigned char* lds, const f16* A, const f16* Bt, int N, int K, int G, int blk, const Epi& E, int wave_s) {
    const int tid = opaque_tid(wave_s), lane = tid & 63, fr = lane & 15, fq = lane >> 4;
    constexpr int RS = 272, BUF = 160 * RS, RG = NTAIL / 128;
    const int ntail = (N / 32) * RG, nb = K / 128;
    typedef const __attribute__((address_space(1))) u32x4* gu4p;
    for (int u = blk; u < ntail; u += G) {
        const int rg = u % RG, cg = u / RG, c0 = 32 * cg, row0 = MAIN + 128 * rg;
        gu4p ga[4]; unsigned la[4];
#pragma unroll
        for (int i = 0; i < 4; ++i) { const int idx = tid + 512 * i, r = idx >> 4, ch = idx & 15; ga[i] = (gu4p)(A + (size_t)(row0 + r) * K + 8 * ch); la[i] = (unsigned)(r * RS + 16 * ch); }
        const int rb = tid >> 4, chb = tid & 15;
        gu4p gb = (gu4p)(Bt + (size_t)(c0 + rb) * K + 8 * chb); const unsigned lb = (unsigned)((128 + rb) * RS + 16 * chb);
        u32x4 ra[4], rbv;
#pragma unroll
        for (int i = 0; i < 4; ++i) ra[i] = ga[i][0];
        rbv = gb[0];
        f32x4 acc0 = {0.f, 0.f, 0.f, 0.f}, acc1 = acc0;
        const unsigned aoff = (unsigned)((16 * wave_s + fr) * RS + 16 * fq), boff0 = (unsigned)((128 + fr) * RS + 16 * fq), boff1 = (unsigned)((144 + fr) * RS + 16 * fq);
#pragma unroll 1
        for (int kb = 0; kb < nb; ++kb) {
            LAS unsigned char* buf = lds + (kb & 1) * BUF;
            if constexpr (Epi::HOOK) { if (kb == (nb >> 1)) E.tail_hook(row0 + 16 * wave_s + fr, c0 + 4 * fq, c0 + 16 + 4 * fq, acc0, acc1); }
#pragma unroll
            for (int i = 0; i < 4; ++i) *(LAS u32x4*)(buf + la[i]) = ra[i];
            *(LAS u32x4*)(buf + lb) = rbv;
            if (kb + 1 < nb) {
#pragma unroll
                for (int i = 0; i < 4; ++i) ra[i] = ga[i][(kb + 1) * 16];
                rbv = gb[(kb + 1) * 16]; }
            __syncthreads();
#pragma unroll
            for (int ks = 0; ks < 4; ++ks) { const f16x8 av = *(const LAS f16x8*)(buf + aoff + 64 * ks), x0 = *(const LAS f16x8*)(buf + boff0 + 64 * ks), x1 = *(const LAS f16x8*)(buf + boff1 + 64 * ks);
                acc0 = __builtin_amdgcn_mfma_f32_16x16x32_f16(x0, av, acc0, 0, 0, 0); acc1 = __builtin_amdgcn_mfma_f32_16x16x32_f16(x1, av, acc1, 0, 0, 0); }
        }
        if constexpr (Epi::AFTER_DRAIN) E.tail_fused(rg, cg, wave_s, fr, fq, acc0, acc1, tid); else E.tail(row0 + 16 * wave_s + fr, c0 >> 8, c0 + 4 * fq, c0 + 16 + 4 * fq, acc0, acc1);
    }
    __syncthreads();
}
}

struct Args {
    const float *x_prompt, *x_sample, *state_hgrn, *state_conv, *meta, *w_in, *lb_logits, *norm_w, *conv_w, *w_a, *w_b, *w_o, *gu1, *dn1, *gu2, *dn2, *ln_g, *ln_b;
    float* out; unsigned char* ws;
};

__device__ __forceinline__ float wave_sum(float v) {
#pragma unroll
    for (int o = 1; o < 64; o <<= 1) v += __shfl_xor(v, o);
    return v;
}

__device__ __forceinline__ void p0_transpose_item(const float* W, int K, int N, f16* WT, int ldk, int koff, int dst_row0, LAS float* scr, int k0, int n0, int lane) {
#pragma unroll 8
    for (int i = 0; i < 32; ++i) { const int kk = 2 * i + (lane >> 5); scr[kk * 33 + (lane & 31)] = W[(size_t)(k0 + kk) * N + n0 + (lane & 31)]; }
    LDS_WAIT(); asm volatile("" ::: "memory");
    const int c = lane & 7;
#pragma unroll
    for (int j = 0; j < 4; ++j) { const int n = (lane >> 3) + 8 * j; const LAS float* s = scr + (8 * c) * 33 + n;
        u32x4 o; o.x = pkh(s[0 * 33], s[1 * 33]); o.y = pkh(s[2 * 33], s[3 * 33]); o.z = pkh(s[4 * 33], s[5 * 33]); o.w = pkh(s[6 * 33], s[7 * 33]);
        *(u32x4*)(WT + (size_t)(dst_row0 + n) * ldk + koff + k0 + 8 * c) = o; }
    LDS_WAIT(); asm volatile("" ::: "memory");
}

__device__ __forceinline__ int gu_dst_row(int c) { int j = c, o = 0; if (c >= DFF) { j = c - DFF; o = 128; } return 256 * (j >> 7) + o + (j & 127); }
__device__ __forceinline__ int in_dst_row(int c) { const int seg = c >> 10; if (seg == 5) { const int j = c - 5120; return 5120 + 256 * (j >> 7) + (j & 127); }
    if (seg == 6) { const int j = c - 6144; return 5120 + 256 * (j >> 7) + 128 + (j & 127); } return c; }

__device__ __forceinline__ void p0_prologue(const Args& a, LAS unsigned char* lds, int blk, int G, int wave_s) {
    const int tid = opaque_tid(wave_s), lane = tid & 63, wave = __builtin_amdgcn_readfirstlane(tid >> 6);
    LAS float* scr = (LAS float*)(lds + wave * 16384);
    const int gw = blk * 8 + wave, NGW = G * 8;
    f16* WB = (f16*)(a.ws + WS_W);
    constexpr int I_GU = 16 * 176, I_DN = 44 * 32, I_IN = 16 * 288, I_SQ = 16 * 32, I_LAYER = 2 * I_GU + 2 * I_DN + I_IN + 3 * I_SQ;
    for (int it = gw; it < I_LAYER * NLAYER; it += NGW) {
        const int l = it / I_LAYER; int r = it % I_LAYER;
        f16* wl = WB + (size_t)l * W_LAYER;
        const float* W; int K, N, type; f16* WT; int ldk = 0, koff = 0;
        if (r < I_GU) { W = a.gu1 + (size_t)l * D * 2 * DFF; K = D; N = 2 * DFF; WT = wl + W_GU1; type = 1; }
        else if ((r -= I_GU) < I_DN) { W = a.dn1 + (size_t)l * DFF * D; K = DFF; N = D; WT = wl + W_DN1; type = 0; }
        else if ((r -= I_DN) < I_IN) { W = a.w_in + (size_t)l * D * NIN; K = D; N = NIN; WT = wl + W_IN; type = 2; }
        else if ((r -= I_IN) < I_SQ) { W = a.w_a + (size_t)l * D * D; K = D; N = D; WT = wl + W_A; type = 0; ldk = 2 * D; }
        else if ((r -= I_SQ) < I_SQ) { W = a.w_b + (size_t)l * D * D; K = D; N = D; WT = wl + W_A; type = 0; ldk = 2 * D; koff = D; }
        else if ((r -= I_SQ) < I_SQ) { W = a.w_o + (size_t)l * D * D; K = D; N = D; WT = wl + W_O; type = 0; }
        else if ((r -= I_SQ) < I_GU) { W = a.gu2 + (size_t)l * D * 2 * DFF; K = D; N = 2 * DFF; WT = wl + W_GU2; type = 1; }
        else { r -= I_GU; W = a.dn2 + (size_t)l * DFF * D; K = DFF; N = D; WT = wl + W_DN2; type = 0; }
        const int nblk = N / 32, kb = r / nblk, nb = r % nblk, n0 = nb * 32;
        const int drow = type == 1 ? gu_dst_row(n0) : type == 2 ? in_dst_row(n0) : n0;
        p0_transpose_item(W, K, N, WT, ldk ? ldk : K, koff, drow, scr, kb * 64, n0, lane);
    }
    float* X = (float*)(a.ws + WS_X); f16* XH = (f16*)(a.ws + WS_XH);
    for (int m = MROWS + gw; m < MPAD; m += NGW) {
#pragma unroll
        for (int j = 0; j < 4; ++j) *(u32x2*)(XH + (size_t)m * D + 256 * j + 4 * lane) = (u32x2){0u, 0u};
    }
    for (int m = gw; m < MROWS; m += NGW) {
        const float* src;
        if (m < MAIN) src = a.x_prompt + (size_t)m * D;
        else if (m < SAMP0) src = a.meta + (size_t)((m - META0) & 15) * D;
        else src = a.x_sample + (size_t)(m - SAMP0) * D;
#pragma unroll
        for (int j = 0; j < 4; ++j) { const f32x4 v = *(const f32x4*)(src + 256 * j + 4 * lane);
            u32x2 w; w.x = pkh(v.x, v.y); w.y = pkh(v.z, v.w); *(u32x2*)(XH + (size_t)m * D + 256 * j + 4 * lane) = w; }
    }
    if (blk == 0) {
        float* LB = (float*)(a.ws + WS_LB);
        for (int c = tid; c < D; c += 512) {
            float e[NLAYER], mx = -1e30f, s = 0.f;
            for (int l = 0; l < NLAYER; ++l) { e[l] = a.lb_logits[l * D + c]; mx = fmaxf(mx, e[l]); }
            for (int l = 0; l < NLAYER; ++l) { e[l] = expf(e[l] - mx); s += e[l]; }
            float cum = 0.f;
            LB[c] = 0.f;
            for (int l = 1; l < NLAYER; ++l) { cum += e[l]; LB[l * D + c] = cum / s; }
        }
    }
}

__device__ __forceinline__ void ln_phase(unsigned char* ws, float* out, const float* g, const float* bta, int blk, int G, bool final_, int wave_s) {
    const int tid = opaque_tid(wave_s), lane = tid & 63, wave = tid >> 6;
    const int gw = blk * 8 + wave, NGW = G * 8;
    const f16* X = (const f16*)(ws + WS_X); f16* XH = (f16*)(ws + WS_XH);
    f32x4 gv[4], bv[4];
#pragma unroll
    for (int j = 0; j < 4; ++j) { gv[j] = *(const f32x4*)(g + 256 * j + 4 * lane); bv[j] = *(const f32x4*)(bta + 256 * j + 4 * lane); }
    for (int m = gw; m < MROWS; m += NGW) {
        const f16* xr = X + (size_t)m * D + 4 * lane;
        f32x4 v[4]; float s = 0.f;
#pragma unroll
        for (int j = 0; j < 4; ++j) { const f16x4 hx = *(const f16x4*)(xr + 256 * j); v[j] = (f32x4){(float)hx.x, (float)hx.y, (float)hx.z, (float)hx.w}; s += (v[j].x + v[j].y) + (v[j].z + v[j].w); }
        const float mean = wave_sum(s) * (1.f / D); float s2 = 0.f;
#pragma unroll
        for (int j = 0; j < 4; ++j) { v[j] = v[j] - mean; s2 += (v[j].x * v[j].x + v[j].y * v[j].y) + (v[j].z * v[j].z + v[j].w * v[j].w); }
        const float rstd = 1.0f / sqrtf(wave_sum(s2) * (1.f / D) + LN_EPS);
        if (!final_) {
#pragma unroll
            for (int j = 0; j < 4; ++j) { const f32x4 y = v[j] * rstd * gv[j] + bv[j];
                u32x2 w; w.x = pkh(y.x, y.y); w.y = pkh(y.z, y.w); *(u32x2*)(XH + (size_t)m * D + 256 * j + 4 * lane) = w; }
        } else {
            float* dst = nullptr;
            if (m < MAIN) dst = out + O_YP + (size_t)m * D;
            else if (m >= SAMP0) dst = out + O_YS + (size_t)(m - SAMP0) * D;
            if (dst) {
#pragma unroll
                for (int j = 0; j < 4; ++j) { const f32x4 y = v[j] * rstd * gv[j] + bv[j]; *(f32x4*)(dst + 256 * j + 4 * lane) = y; }
            }
        }
    }
}

constexpr int H_SH = 0, SH_STRIDE = 272, SH_SZ = 32 * SH_STRIDE, H_P = 4 * SH_SZ, P_STRIDE = 48;
constexpr int QS_STRIDE = 272, KT_STRIDE = 144;
constexpr int VT_SZ = 32 * KT_STRIDE, QH_SZ = 64 * QS_STRIDE;
constexpr int H_VT0 = H_P + 64 * P_STRIDE, H_QH0 = H_VT0 + 2 * VT_SZ;
constexpr int H_QB = H_QH0 + 2 * QH_SZ, H_KO = H_QB + 64 * QS_STRIDE, H_KT = H_KO + 64 * QS_STRIDE, H_ES = H_KT + 128 * KT_STRIDE, H_END = H_ES + 2048;
static_assert(H_END <= XB_LDS_OFF && (H_VT0 % 16) == 0 && (H_QH0 % 16) == 0 && (H_QB % 16) == 0 && (H_KT % 16) == 0 && (H_ES % 16) == 0, "hgrn lds map");

__device__ __forceinline__ void hgrn_prompt_item(unsigned char* ws, float* out, LAS unsigned char* lds, int l, int item, int wave_s) {
    const int tid = opaque_tid(wave_s), lane = tid & 63, wave = __builtin_amdgcn_readfirstlane(tid >> 6), fr = lane & 15, fq = lane >> 4;
    const int bh = item >> 2, dvs = item & 3, b = bh >> 3, h = bh & 7;
    const f16* Q = (const f16*)(ws + WS_Q); const float* LF = (const float*)(ws + WS_LF); const f16* V = (const f16*)(ws + WS_V);
    f16* OR = (f16*)(ws + WS_MM); float* SS = (float*)(ws + WS_SS);
    const size_t rowb = (size_t)b * SEQP, rowm = (size_t)META0 + (size_t)b * NMETA;
    f32x4 S[2] = {{0.f, 0.f, 0.f, 0.f}, {0.f, 0.f, 0.f, 0.f}};
    const int ti = wave >> 1, hh = lane >> 5, dp = 32 * (wave & 1) + (lane & 31), tt0 = 16 * ti + 8 * hh;
    f32x2 pF[8]; unsigned pQ2[8]; u32x4 pV;
#define HG_LOAD(c) do { const size_t _rb = (c) == 0 ? rowm : rowb + 64 * ((c) - 1); const int _L = (c) == 0 ? 16 : 64; \
        _Pragma("unroll") for (int k = 0; k < 8; ++k) { pF[k] = (f32x2){1.f, 1.f}; pQ2[k] = 0u; \
            if (tt0 + k < _L) { pF[k] = *(const f32x2*)(LF + (_rb + tt0 + k) * D + 128 * h + 2 * dp); pQ2[k] = *(const unsigned*)(Q + (_rb + tt0 + k) * D + 128 * h + 2 * dp); } } \
        { const int r = tid >> 2, cc = tid & 3; pV = (u32x4){0u, 0u, 0u, 0u}; if (r < _L) pV = *(const u32x4*)(V + (_rb + r) * D + 128 * h + 32 * dvs + 8 * cc); } } while (0)
    HG_LOAD(0);
    constexpr int NCH = 33;
    for (int c = 0; c < NCH; ++c) {
        const size_t rbase = c == 0 ? rowm : rowb + 64 * (c - 1); const int L = c == 0 ? 16 : 64;
        const int H_VT = H_VT0 + (c & 1) * VT_SZ, H_QH = H_QH0 + (c & 1) * QH_SZ;
        if (tid < 256) { const int r = tid >> 2, cc = tid & 3;
#pragma unroll
            for (int e = 0; e < 4; ++e) { const unsigned w = pV[e]; *(LAS unsigned short*)(lds + H_VT + (8 * cc + 2 * e) * KT_STRIDE + 2 * r) = (unsigned short)(w & 0xffffu);
                *(LAS unsigned short*)(lds + H_VT + (8 * cc + 2 * e + 1) * KT_STRIDE + 2 * r) = (unsigned short)(w >> 16); } }
        {
            f32x2 eb[8]; f32x2 run = {1.f, 1.f};
#pragma unroll
            for (int k = 0; k < 8; ++k) { run = run * pF[k]; eb[k] = run; }
            f32x2 oth; oth.x = __shfl_xor(run.x, 32); oth.y = __shfl_xor(run.y, 32);
            const f32x2 bc = run * oth;
            const f32x2 pre = hh ? oth : (f32x2){1.f, 1.f};
            unsigned kt0[4], kt1[4];
#pragma unroll
            for (int k = 0; k < 8; ++k) {
                const f32x2 e = eb[k] * pre; const f16x2 qh2 = __builtin_bit_cast(f16x2, pQ2[k]);
                const f32x2 q = {(float)qh2.x, (float)qh2.y}, kk = (f32x2){1.f, 1.f} - pF[k];
                f32x2 inv; inv.x = __builtin_amdgcn_rcpf(fmaxf(e.x, 1e-30f)); inv.y = __builtin_amdgcn_rcpf(fmaxf(e.y, 1e-30f));
                const f32x2 qh = q * e, ko = kk * inv, ke = ko * bc;
                const int trow = (tt0 + k) * QS_STRIDE + dp * 4;
                *(LAS unsigned*)(lds + H_QH + trow) = pkh(qh.x, qh.y);
                *(LAS unsigned*)(lds + H_QB + trow) = pkb(qh.x, qh.y);
                *(LAS unsigned*)(lds + H_KO + trow) = pkb(ko.x, ko.y);
                const unsigned short h0 = __builtin_bit_cast(unsigned short, (f16)ke.x), h1 = __builtin_bit_cast(unsigned short, (f16)ke.y);
                if (k & 1) { kt0[k >> 1] |= (unsigned)h0 << 16; kt1[k >> 1] |= (unsigned)h1 << 16; } else { kt0[k >> 1] = h0; kt1[k >> 1] = h1; }
            }
            *(LAS u32x4*)(lds + H_KT + (2 * dp) * KT_STRIDE + 2 * tt0) = (u32x4){kt0[0], kt0[1], kt0[2], kt0[3]};
            *(LAS u32x4*)(lds + H_KT + (2 * dp + 1) * KT_STRIDE + 2 * tt0) = (u32x4){kt1[0], kt1[1], kt1[2], kt1[3]};
            if (hh == 0) *(LAS f32x2*)(lds + H_ES + (ti * 128 + 2 * dp) * 4) = bc;
        }
        if (c + 1 < NCH) HG_LOAD(c + 1);
        __syncthreads();
        if (wave < 4) {
            const int i = wave; f32x4 p = {0.f, 0.f, 0.f, 0.f};
#pragma unroll
            for (int ks = 0; ks < 4; ++ks) { const s16x8 qa = *(const LAS s16x8*)(lds + H_QB + (16 * i + fr) * QS_STRIDE + 64 * ks + 16 * fq);
                const s16x8 kb = *(const LAS s16x8*)(lds + H_KO + (16 * i + fr) * QS_STRIDE + 64 * ks + 16 * fq);
                p = __builtin_amdgcn_mfma_f32_16x16x32_bf16(kb, qa, p, 0, 0, 0); }
            u32x2 w; w.x = pkh((4 * fq + 0 <= fr) ? p[0] : 0.f, (4 * fq + 1 <= fr) ? p[1] : 0.f); w.y = pkh((4 * fq + 2 <= fr) ? p[2] : 0.f, (4 * fq + 3 <= fr) ? p[3] : 0.f);
            *(LAS u32x2*)(lds + H_P + (16 * i + fr) * P_STRIDE + 8 * fq) = w;
        }
        {
            const int dd = 16 * wave + fr, d4 = 16 * wave + 4 * fq;
#pragma unroll
            for (int i = 0; i < 4; ++i) {
#pragma unroll
                for (int vt = 0; vt < 2; ++vt) { u32x2 w; w.x = pkh(S[vt][0], S[vt][1]); w.y = pkh(S[vt][2], S[vt][3]);
                    *(LAS u32x2*)(lds + H_SH + i * SH_SZ + (16 * vt + fr) * SH_STRIDE + d4 * 2) = w; }
                const f32x4 sc = *(const LAS f32x4*)(lds + H_ES + (i * 128 + d4) * 4);
                f16x8 kb = {0, 0, 0, 0, 0, 0, 0, 0}, va0 = kb, va1 = kb;
                if (fq < 2) { kb = *(const LAS f16x8*)(lds + H_KT + dd * KT_STRIDE + 32 * i + 16 * fq);
                    va0 = *(const LAS f16x8*)(lds + H_VT + fr * KT_STRIDE + 32 * i + 16 * fq); va1 = *(const LAS f16x8*)(lds + H_VT + (16 + fr) * KT_STRIDE + 32 * i + 16 * fq); }
                S[0] = S[0] * sc; S[1] = S[1] * sc;
                S[0] = __builtin_amdgcn_mfma_f32_16x16x32_f16(kb, va0, S[0], 0, 0, 0);
                S[1] = __builtin_amdgcn_mfma_f32_16x16x32_f16(kb, va1, S[1], 0, 0, 0);
            }
        }
        __syncthreads();
        {
            const int i = wave >> 1, vt = wave & 1; f32x4 o = {0.f, 0.f, 0.f, 0.f};
            f16x8 pa = {0, 0, 0, 0, 0, 0, 0, 0}, vb = pa;
            if (fq < 2) { pa = *(const LAS f16x8*)(lds + H_P + (16 * i + fr) * P_STRIDE + 16 * fq); vb = *(const LAS f16x8*)(lds + H_VT + (16 * vt + fr) * KT_STRIDE + 32 * i + 16 * fq); }
            o = __builtin_amdgcn_mfma_f32_16x16x32_f16(vb, pa, o, 0, 0, 0);
#pragma unroll
            for (int ks = 0; ks < 4; ++ks) { const f16x8 qa = *(const LAS f16x8*)(lds + H_QH + (16 * i + fr) * QS_STRIDE + 64 * ks + 16 * fq);
                const f16x8 sb = *(const LAS f16x8*)(lds + H_SH + i * SH_SZ + (16 * vt + fr) * SH_STRIDE + 64 * ks + 16 * fq);
                o = __builtin_amdgcn_mfma_f32_16x16x32_f16(sb, qa, o, 0, 0, 0); }
            float sq = (o[0] * o[0] + o[1] * o[1]) + (o[2] * o[2] + o[3] * o[3]);
            sq += __shfl_xor(sq, 16); sq += __shfl_xor(sq, 32);
            const int t = 16 * i + fr;
            if (t < L) { const size_t row = rbase + t; u32x2 w; w.x = pkh(o[0], o[1]); w.y = pkh(o[2], o[3]);
                *(u32x2*)(OR + row * D + 128 * h + 32 * dvs + 16 * vt + 4 * fq) = w; if (fq == 0) SS[row * 64 + h * 8 + dvs * 2 + vt] = sq; }
        }
    }
#undef HG_LOAD
    __syncthreads();
    float* outS = out + O_HP + ((((size_t)l * BP + b) * NH + h) * DK + (16 * wave + 4 * fq)) * DV + 32 * dvs + fr;
#pragma unroll
    for (int j = 0; j < 4; ++j) { outS[(size_t)j * DV] = S[0][j]; outS[(size_t)j * DV + 16] = S[1][j]; }
}

__device__ __forceinline__ void hgrn_sample_item(unsigned char* ws, float* out, const float* state_hgrn, LAS unsigned char* lds, int l, int item, int wave_s) {
    const int tid = opaque_tid(wave_s), lane = tid & 63;
    const int bs = item >> 3, h = item & 7;
    const f16* Q = (const f16*)(ws + WS_Q); const float* LF = (const float*)(ws + WS_LF); const f16* V = (const f16*)(ws + WS_V);
    f16* OR = (f16*)(ws + WS_MM); float* SS = (float*)(ws + WS_SS);
    LAS float* sq = (LAS float*)lds; LAS float* sf = sq + 512; LAS float* sk = sf + 512; LAS float* sv = sk + 512; LAS float* red = sv + 512;
    const size_t row0 = (size_t)SAMP0 + (size_t)bs * TS;
    { const int t = tid >> 7, d = tid & 127; const size_t o = (row0 + t) * D + 128 * h + d; const float f = LF[o];
      sq[tid] = (float)Q[o]; sf[tid] = f; sk[tid] = 1.0f - f; sv[tid] = (float)V[o]; }
    const int vq = tid & 31, dg = tid >> 5;
    const size_t sbase = ((((size_t)l * BS + bs) * NH + h) * DK + 8 * dg) * DV + 4 * vq;
    f32x4 S[8];
#pragma unroll
    for (int dd = 0; dd < 8; ++dd) S[dd] = *(const f32x4*)(state_hgrn + sbase + (size_t)dd * DV);
    __syncthreads();
#pragma unroll
    for (int t = 0; t < TS; ++t) {
        const f32x4 vv = *(const LAS f32x4*)(sv + t * 128 + 4 * vq); f32x4 po = {0.f, 0.f, 0.f, 0.f};
#pragma unroll
        for (int dd = 0; dd < 8; ++dd) { const int d = t * 128 + 8 * dg + dd; const float f = sf[d], k = sk[d], q = sq[d]; S[dd] = S[dd] * f + vv * k; po += S[dd] * q; }
        *(LAS f32x4*)(red + (t * 16 + dg) * 128 + 4 * vq) = po;
    }
    __syncthreads();
    { const int t = tid >> 7, v = tid & 127; float o = 0.f;
#pragma unroll
      for (int g = 0; g < 16; ++g) o += red[(t * 16 + g) * 128 + v];
      const size_t row = row0 + t; OR[row * D + 128 * h + v] = (f16)o;
      const float s = wave_sum(o * o);
      if (lane < 4) SS[row * 64 + h * 8 + ((tid >> 6) & 1) * 4 + lane] = lane == 0 ? s : 0.f; }
    float* outS = out + O_HS + sbase;
#pragma unroll
    for (int dd = 0; dd < 8; ++dd) *(f32x4*)(outS + (size_t)dd * DV) = S[dd];
    __syncthreads();
}

__device__ __forceinline__ void mix_post_phase(unsigned char* ws, float* out, const float* norm_w, const float* conv_w, const float* state_conv, int l, int blk, int G, int wave_s) {
    const int tid = opaque_tid(wave_s);
    const f16* O = (const f16*)(ws + WS_MM); const float* SS = (const float*)(ws + WS_SS); const f16* SOG = (const f16*)(ws + WS_SOG);
    const f16* BG = (const f16*)(ws + WS_BG); const f16* U = (const f16*)(ws + WS_U); f16* AB = (f16*)(ws + WS_O);
    const float* nw = norm_w + (size_t)l * DV; const float* cw = conv_w + (size_t)l * 3 * D;
    for (int idx = blk * 512 + tid; idx < MROWS * 128; idx += G * 512) {
        const int row = idx >> 7, c8 = idx & 127, col = 8 * c8, head = c8 >> 4;
        const size_t o = (size_t)row * D + col;
        const f32x4 s0 = *(const f32x4*)(SS + (size_t)row * 64 + head * 8), s1 = *(const f32x4*)(SS + (size_t)row * 64 + head * 8 + 4);
        const float ms = ((s0.x + s0.y) + (s0.z + s0.w) + (s1.x + s1.y) + (s1.z + s1.w)) * (1.f / DV);
        const float r = 1.0f / sqrtf(ms + RMS_EPS);
        const f16x8 ov = *(const f16x8*)(O + o), gv = *(const f16x8*)(SOG + o);
        const f32x4 w0 = *(const f32x4*)(nw + (col & 127)), w1 = *(const f32x4*)(nw + (col & 127) + 4);
        float res[8];
#pragma unroll
        for (int e = 0; e < 8; ++e) res[e] = (float)ov[e] * r * (e < 4 ? w0[e] : w1[e - 4]) * (float)gv[e];
        u32x4 w; w.x = pkh(res[0], res[1]); w.y = pkh(res[2], res[3]); w.z = pkh(res[4], res[5]); w.w = pkh(res[6], res[7]);
        *(u32x4*)(AB + (size_t)row * 2 * D + col) = w;
        int t, T; const float* buf = nullptr; float* nb = nullptr; size_t o1 = o - D, o2 = o - 2 * D;
        if (row < MAIN) { const int b = row >> 11, tp = row & 2047; t = tp + NMETA; T = TP; nb = out + O_CP + ((size_t)l * BP + b) * 2 * D;
            if (tp < 1) o1 = (size_t)(META0 + b * NMETA + 15) * D + col;
            if (tp < 2) o2 = (size_t)(META0 + b * NMETA + 14 + tp) * D + col; }
        else if (row < SAMP0) { t = (row - META0) & 15; T = TP; }
        else { const int bs = (row - SAMP0) >> 2; t = (row - SAMP0) & 3; T = TS; buf = state_conv + ((size_t)l * BS + bs) * 2 * D; nb = out + O_CS + ((size_t)l * BS + bs) * 2 * D; }
        const f16x8 u2 = *(const f16x8*)(U + o);
        float um1[8], um2[8];
#pragma unroll
        for (int e = 0; e < 8; ++e) { um1[e] = 0.f; um2[e] = 0.f; }
        if (t >= 1) { const f16x8 x = *(const f16x8*)(U + o1);
#pragma unroll
            for (int e = 0; e < 8; ++e) um1[e] = (float)x[e]; }
        else if (buf) {
#pragma unroll
            for (int e = 0; e < 8; ++e) um1[e] = buf[D + col + e]; }
        if (t >= 2) { const f16x8 x = *(const f16x8*)(U + o2);
#pragma unroll
            for (int e = 0; e < 8; ++e) um2[e] = (float)x[e]; }
        else if (buf) {
#pragma unroll
            for (int e = 0; e < 8; ++e) um2[e] = buf[(size_t)t * D + col + e]; }
        const f16x8 bg = *(const f16x8*)(BG + o);
        float cr[8];
#pragma unroll
        for (int e = 0; e < 8; ++e) cr[e] = (float)bg[e] * (cw[col + e] * um2[e] + cw[D + col + e] * um1[e] + cw[2 * D + col + e] * (float)u2[e]);
        u32x4 cwv; cwv.x = pkh(cr[0], cr[1]); cwv.y = pkh(cr[2], cr[3]); cwv.z = pkh(cr[4], cr[5]); cwv.w = pkh(cr[6], cr[7]);
        *(u32x4*)(AB + (size_t)row * 2 * D + D + col) = cwv;
        if (t >= T - 2 && nb) { float* p = nb + (size_t)(t - (T - 2)) * D + col;
#pragma unroll
            for (int e = 0; e < 8; ++e) p[e] = (float)u2[e]; }
    }
}

#define XB_TMO      128
#define XB_XCNT(j)  (256  + 64 * (j))
#define XB_XSUB(j)  (1280 + 64 * (j))
#define XB_XGEN(j)  (2304 + 64 * (j))
#define XB_TOP      3328
#define XB_TOPGEN   3392
#define XCD_BAR_WORDS 3456
#define XB_SPIN_CAP (1u << 18)
__device__ __forceinline__ unsigned xb_ld(unsigned* p)              { return __hip_atomic_load(p, __ATOMIC_RELAXED, __HIP_MEMORY_SCOPE_AGENT); }
__device__ __forceinline__ unsigned xb_add(unsigned* p, unsigned v) { return __hip_atomic_fetch_add(p, v, __ATOMIC_RELAXED, __HIP_MEMORY_SCOPE_AGENT); }
__device__ __forceinline__ unsigned xb_xcc_id() { return (unsigned)__builtin_amdgcn_s_getreg((3 << 11) | 20) & 0xFu; }
#define XB_SPIN(cond, bar) do { unsigned _sp = 0; while (cond) { __builtin_amdgcn_s_sleep(1); \
    if ((++_sp & 255u) == 0u) { if (xb_ld(&(bar)[XB_TMO])) break; if (_sp > XB_SPIN_CAP) { atomicAdd(&(bar)[XB_TMO], 1u); break; } } } } while (0)
struct XcdBarrier { unsigned* bar; unsigned x; volatile LAS unsigned* st; };
__device__ __forceinline__ void xcd_barrier_complete(unsigned* bar, unsigned x, unsigned& nloc, unsigned& nx) {
    const unsigned G = gridDim.x * gridDim.y * gridDim.z;
    unsigned sum, cnt, mine, sp = 0u;
    for (;;) {
        sum = 0u; cnt = 0u; mine = 0u;
#pragma unroll
        for (unsigned j = 0; j < 16; ++j) { const unsigned c = xb_ld(&bar[XB_XCNT(j)]); sum += c; cnt += (c > 0u) ? 1u : 0u; mine = (j == x) ? c : mine; }
        if (sum == G) break;
        __builtin_amdgcn_s_sleep(1);
        if ((++sp & 255u) == 0u) { if (xb_ld(&bar[XB_TMO])) break; if (sp > XB_SPIN_CAP) { atomicAdd(&bar[XB_TMO], 1u); break; } }
    }
    nloc = mine > 0u ? mine : 1u; nx = cnt > 0u ? cnt : 1u;
}
__device__ __forceinline__ void xcd_barrier(const XcdBarrier& b, int tid) {
    asm volatile("s_waitcnt vmcnt(0)" ::: "memory");
    __syncthreads();
    if (tid == 0) {
        unsigned* bar = b.bar;
        __builtin_amdgcn_s_waitcnt(0);
        unsigned nloc = b.st[0], nx = b.st[1];
        if (nloc == 0u) { xcd_barrier_complete(bar, b.x, nloc, nx); b.st[0] = nloc; b.st[1] = nx; }
        const unsigned old = xb_add(&bar[XB_XSUB(b.x)], 1u);
        const unsigned gen = old / nloc;
        if (old + 1u == (gen + 1u) * nloc) {
            __builtin_amdgcn_fence(__ATOMIC_RELEASE, "agent");
            asm volatile("s_waitcnt vmcnt(0)" ::: "memory");
            const unsigned og = xb_add(&bar[XB_TOP], 1u);
            const unsigned tg = og / nx;
            if (og + 1u == (tg + 1u) * nx) xb_add(&bar[XB_TOPGEN], 1u);
            else XB_SPIN(xb_ld(&bar[XB_TOPGEN]) == tg, bar);
            __builtin_amdgcn_fence(__ATOMIC_ACQUIRE, "agent");
            xb_add(&bar[XB_XGEN(b.x)], 1u);
            asm volatile("s_waitcnt vmcnt(0)" ::: "memory");
        } else {
            XB_SPIN(xb_ld(&bar[XB_XGEN(b.x)]) == gen, bar);
            __builtin_amdgcn_fence(__ATOMIC_ACQUIRE, "agent");
            asm volatile("s_waitcnt vmcnt(0)" ::: "memory");
        }
    }
    __syncthreads();
}

__global__ void __launch_bounds__(512, 2) mega_fwd(Args a) {
    extern __shared__ __attribute__((aligned(16))) unsigned char lds_raw[];
    LAS unsigned char* lds = (LAS unsigned char*)lds_raw;
#define WSP() karg<19>()
#define LDSP() ({ LAS unsigned char* _p = lds; asm volatile("" : "+s"(_p)); _p; })
    const int blk = blockIdx.x, G = gridDim.x;
    const int vcu = (G % 8 == 0) ? (blk % 8) * (G / 8) + blk / 8 : blk;
    const int wave_s = __builtin_amdgcn_readfirstlane((int)threadIdx.x >> 6);
    volatile LAS unsigned* xst = (volatile LAS unsigned*)(lds + XB_LDS_OFF);
    if (threadIdx.x < 4) xst[threadIdx.x] = 0u;
    __syncthreads();
    XcdBarrier xbar; xbar.bar = (unsigned*)(a.ws + WS_CTL) + 4096; xbar.x = xb_xcc_id(); xbar.st = xst;
    if (threadIdx.x == 0) (void)xb_add(&xbar.bar[XB_XCNT(xbar.x)], 1u);
#define GRID_BAR() do { XcdBarrier _xb; _xb.bar = (unsigned*)(karg<19>() + WS_CTL) + 4096; _xb.x = xb_xcc_id(); _xb.st = (volatile LAS unsigned*)(LDSP() + XB_LDS_OFF); xcd_barrier(_xb, opaque_tid(wave_s)); } while (0)
    p0_prologue(a, lds, vcu, G, wave_s);
    if (a.out == nullptr) { cg::grid_group grid = cg::this_grid(); grid.sync(); }
    GRID_BAR();
    for (int l = 0; l < NLAYER; ++l) {
#define WL() ((const f16*)(WSP() + WS_W) + (size_t)l * W_LAYER)
        pg8::StaticOrder S;
        { unsigned char* ws = WSP(); pg8::Gemm g{(const f16*)(ws + WS_XH), WL() + W_GU1, MPAD, 2 * DFF, D}; S.init(MPAD, 2 * DFF, opaque_s(G), opaque_s(blk)); pg8::EpiGU E{(f16*)(ws + WS_H)}; pg8::gemm_phase(LDSP(), g, S, E, wave_s); }
        GRID_BAR();
        { unsigned char* ws = WSP(); pg8::Gemm g{(const f16*)(ws + WS_H), WL() + W_DN1, MAIN, D, DFF}; S.init(MAIN, D, opaque_s(G), opaque_s(blk)); pg8::EpiResLN E{(const f16*)(ws + WS_XH), (f16*)(ws + WS_XH), ((float*)nullptr), 0.5f, (const float*)karg<16>() + (size_t)l * 3 * D + 0 * D, (const float*)karg<17>() + (size_t)l * 3 * D + 0 * D, ws + WS_X, (unsigned*)(ws + WS_CTL) + CW_PANEL, (unsigned)(l * 3 + 0) + 1u}; pg8::gemm_phase(LDSP(), g, S, E, wave_s);
          pg8::tail_gemm_lds(LDSP(), g.A, g.Bt, g.N, g.K, opaque_s(G), opaque_s(blk), E, wave_s); }
        GRID_BAR();
        { unsigned char* ws = WSP(); pg8::Gemm g{(const f16*)(ws + WS_XH), WL() + W_IN, MPAD, NIN, D}; S.init(MPAD, NIN, opaque_s(G), opaque_s(blk));
          pg8::EpiIn E{(f16*)(ws + WS_Q), (f16*)(ws + WS_V), (f16*)(ws + WS_SOG), (f16*)(ws + WS_BG), (f16*)(ws + WS_U), (f16*)(ws + WS_SGA), (f16*)(ws + WS_SGB),
                       (float*)(ws + WS_LF), (const float*)(ws + WS_LB) + (size_t)l * D};
          pg8::gemm_phase(LDSP(), g, S, E, wave_s); }
        GRID_BAR();
        {
            for (int it = blk; it < 256; it += G) { const int item = ((it & 7) * 8 + (it >> 5)) * 4 + ((it >> 3) & 3); hgrn_prompt_item(WSP(), (float*)karg<18>(), LDSP(), l, item, wave_s); }
            for (int it = blk; it < BS * NH; it += G) hgrn_sample_item(WSP(), (float*)karg<18>(), (const float*)karg<2>(), LDSP(), l, it, wave_s);
        }
        GRID_BAR();
        mix_post_phase(WSP(), (float*)karg<18>(), (const float*)karg<7>(), (const float*)karg<8>(), (const float*)karg<3>(), l, opaque_s(vcu), opaque_s(G), wave_s);
        GRID_BAR();
        { unsigned char* ws = WSP(); pg8::Gemm g{(const f16*)(ws + WS_O), WL() + W_A, MAIN, D, 2 * D}; S.init(MAIN, D, opaque_s(G), opaque_s(blk));
          pg8::EpiMerge E{(const f16*)(ws + WS_SGA), (const f16*)(ws + WS_SGB), (f16*)(ws + WS_MM)}; pg8::gemm_phase(LDSP(), g, S, E, wave_s);
          pg8::tail_gemm_lds(LDSP(), g.A, g.Bt, g.N, g.K, opaque_s(G), opaque_s(blk), E, wave_s); }
        GRID_BAR();
        { unsigned char* ws = WSP(); pg8::Gemm g{(const f16*)(ws + WS_MM), WL() + W_O, MAIN, D, D}; S.init(MAIN, D, opaque_s(G), opaque_s(blk)); pg8::EpiResLN E{(const f16*)(ws + WS_XH), (f16*)(ws + WS_XH), ((float*)nullptr), 1.0f, (const float*)karg<16>() + (size_t)l * 3 * D + 1 * D, (const float*)karg<17>() + (size_t)l * 3 * D + 1 * D, ws + WS_X, (unsigned*)(ws + WS_CTL) + CW_PANEL, (unsigned)(l * 3 + 1) + 1u}; pg8::gemm_phase(LDSP(), g, S, E, wave_s);
          pg8::tail_gemm_lds(LDSP(), g.A, g.Bt, g.N, g.K, opaque_s(G), opaque_s(blk), E, wave_s); }
        GRID_BAR();
        { unsigned char* ws = WSP(); pg8::Gemm g{(const f16*)(ws + WS_XH), WL() + W_GU2, MPAD, 2 * DFF, D}; S.init(MPAD, 2 * DFF, opaque_s(G), opaque_s(blk)); pg8::EpiGU E{(f16*)(ws + WS_H)}; pg8::gemm_phase(LDSP(), g, S, E, wave_s); }
        GRID_BAR();
        { unsigned char* ws = WSP(); pg8::Gemm g{(const f16*)(ws + WS_H), WL() + W_DN2, MAIN, D, DFF}; S.init(MAIN, D, opaque_s(G), opaque_s(blk)); pg8::EpiResLN E{(const f16*)(ws + WS_XH), (f16*)(ws + WS_XH), ((l == NLAYER - 1) ? (float*)karg<18>() + O_YP : (float*)nullptr), 0.5f, (const float*)karg<16>() + (size_t)l * 3 * D + 2 * D, (const float*)karg<17>() + (size_t)l * 3 * D + 2 * D, ws + WS_X, (unsigned*)(ws + WS_CTL) + CW_PANEL, (unsigned)(l * 3 + 2) + 1u}; pg8::gemm_phase(LDSP(), g, S, E, wave_s);
          pg8::tail_gemm_lds(LDSP(), g.A, g.Bt, g.N, g.K, opaque_s(G), opaque_s(blk), E, wave_s); }
        GRID_BAR();
    }
}

extern "C" void kernel_launch(void* const* d_in, const int* in_sizes, int n_in, void* d_out, int out_size, void* d_ws, size_t ws_size, hipStream_t stream) {
    static int inited = 0;
    if (!inited) {
        if (ws_size < WS_END) fprintf(stderr, "kernel_launch: workspace too small: %zu < %zu\n", ws_size, (size_t)WS_END);
        (void)hipFuncSetAttribute((const void*)mega_fwd, hipFuncAttributeMaxDynamicSharedMemorySize, LDS_BYTES);
        inited = 1;
    }
    Args a{};
    a.x_prompt = (const float*)d_in[0]; a.x_sample = (const float*)d_in[1]; a.state_hgrn = (const float*)d_in[2]; a.state_conv = (const float*)d_in[3];
    a.meta = (const float*)d_in[4]; a.w_in = (const float*)d_in[5]; a.lb_logits = (const float*)d_in[6]; a.norm_w = (const float*)d_in[7]; a.conv_w = (const float*)d_in[8];
    a.w_a = (const float*)d_in[9]; a.w_b = (const float*)d_in[10]; a.w_o = (const float*)d_in[11]; a.gu1 = (const float*)d_in[12]; a.dn1 = (const float*)d_in[13];
    a.gu2 = (const float*)d_in[14]; a.dn2 = (const float*)d_in[15]; a.ln_g = (const float*)d_in[16]; a.ln_b = (const float*)d_in[17];
    a.out = (float*)d_out; a.ws = (unsigned char*)d_ws;
    if (hipMemsetAsync((char*)d_ws + WS_CTL, 0, 65536, stream) != hipSuccess) fprintf(stderr, "memset failed\n");
    void* args[] = {&a};
    hipError_t e = hipLaunchCooperativeKernel((const void*)mega_fwd, dim3(256), dim3(512), args, LDS_BYTES, stream);
    if (e != hipSuccess) fprintf(stderr, "cooperative launch failed: %s\n", hipGetErrorString(e));
}
```
